# Optimizing an MI355X kernel written in HIP

```python
import jax, jax.numpy as jnp
from jax import lax
import numpy as np

D_MODEL = 2048
BATCH = 1
SEQ = 8192
DEPTH = 2

N_A_LAYERS = DEPTH // 2
N_B_LAYERS = DEPTH - N_A_LAYERS
RMS_EPS = 1e-6
GATED_NORM_EPS = 1e-5

SSM_EXPAND = 2
D_INNER = SSM_EXPAND * D_MODEL
SSM_HEAD_DIM = 64
SSM_HEADS = D_INNER // SSM_HEAD_DIM
SSM_GROUPS = 8
SSM_HEADS_PER_GROUP = SSM_HEADS // SSM_GROUPS
SSM_STATE = 128
D_CONV = 4
CONV_DIM = D_INNER + 2 * SSM_GROUPS * SSM_STATE
D_IN_PROJ = 2 * D_INNER + 2 * SSM_GROUPS * SSM_STATE + SSM_HEADS
SSD_CHUNK = 256

FOX_HEADS = 16
FOX_HEAD_DIM = D_MODEL // FOX_HEADS
ATT_DIM = FOX_HEADS * FOX_HEAD_DIM
FOX_Q_BLOCK = 128
FOX_SCALE = FOX_HEAD_DIM ** -0.5

PEER_HEADS = 8
PEER_N_KEYS = 128
PEER_EXPERTS = PEER_N_KEYS * PEER_N_KEYS
PEER_TOPK = 16
PEER_QUERY_DIM = 256
PEER_HALF = PEER_QUERY_DIM // 2
PEER_TOKEN_BLOCK = 128

PLE_DIM = 256

kernel_name = 'yoco_ssd_fox_peer_ple_trunk'


def rms_norm(x, w, eps=RMS_EPS):
    xf = x.astype(jnp.float32)
    y = xf * lax.rsqrt(jnp.mean(xf * xf, axis=-1, keepdims=True) + eps)
    return y.astype(x.dtype) * w


def causal_depthwise_conv(x, w, b):
    s = x.shape[1]
    xp = jnp.pad(x, ((0, 0), (D_CONV - 1, 0), (0, 0)))
    y = b + w[0] * xp[:, 0:s]
    for k in range(1, D_CONV):
        y = y + w[k] * xp[:, k:k + s]
    return y


def ssd_chunked_scan(xh, dt, A, Bm, Cm):
    b, s, g, r, p = xh.shape
    n = Bm.shape[-1]
    pad = (-s) % SSD_CHUNK
    if pad:
        padf = lambda t: jnp.pad(t, ((0, 0), (0, pad)) + ((0, 0),) * (t.ndim - 2))
        xh, dt, Bm, Cm = padf(xh), padf(dt), padf(Bm), padf(Cm)
    nc = (s + pad) // SSD_CHUNK
    chunks = lambda t: jnp.moveaxis(t.reshape((b, nc, SSD_CHUNK) + t.shape[2:]), 1, 0)
    xc, dtc, Bc, Cc = chunks(xh), chunks(dt), chunks(Bm), chunks(Cm)
    acum = jnp.cumsum(dtc * A, axis=2)
    tril = jnp.tril(jnp.ones((SSD_CHUNK, SSD_CHUNK), bool))[None, :, :, None, None]

    def step(state, inp):
        x, dtl, ac, Bl, Cl = inp
        seg = ac[:, :, None] - ac[:, None, :]
        decay = jnp.exp(jnp.where(tril, seg, -jnp.inf))
        cb = jnp.einsum('blgn,bsgn->blsg', Cl, Bl)
        y_intra = jnp.einsum('blsg,blsgr,bsgr,bsgrp->blgrp', cb, decay, dtl, x)
        y_inter = jnp.einsum('blgn,bgrpn,blgr->blgrp', Cl, state, jnp.exp(ac))
        last = ac[:, -1]
        w = jnp.exp(last[:, None] - ac) * dtl
        new_state = state * jnp.exp(last)[..., None, None] + jnp.einsum('blgr,blgrp,blgn->bgrpn', w, x, Bl)
        return new_state, y_intra + y_inter

    init = jnp.zeros((b, g, r, p, n), jnp.float32)
    _, ys = lax.scan(step, init, (xc, dtc, acum, Bc, Cc))
    return jnp.moveaxis(ys, 0, 1).reshape(b, nc * SSD_CHUNK, g, r, p)[:, :s]


def mamba2_mixer(h, norm_w, w_in, conv_w, conv_b, dt_bias, A_log, D_skip, gnorm_w, w_out):
    b, s, _ = h.shape
    zxbcdt = rms_norm(h, norm_w) @ w_in
    z = zxbcdt[..., :D_INNER]
    xbc = zxbcdt[..., D_INNER:D_INNER + CONV_DIM]
    dt_raw = zxbcdt[..., D_INNER + CONV_DIM:]
    xbc = jax.nn.silu(causal_depthwise_conv(xbc, conv_w, conv_b))
    gn = SSM_GROUPS * SSM_STATE
    xs = xbc[..., :D_INNER].reshape(b, s, SSM_GROUPS, SSM_HEADS_PER_GROUP, SSM_HEAD_DIM)
    Bm = xbc[..., D_INNER:D_INNER + gn].reshape(b, s, SSM_GROUPS, SSM_STATE)
    Cm = xbc[..., D_INNER + gn:].reshape(b, s, SSM_GROUPS, SSM_STATE)
    dt = jax.nn.softplus(dt_raw.astype(jnp.float32) + dt_bias.astype(jnp.float32))
    dt = dt.reshape(b, s, SSM_GROUPS, SSM_HEADS_PER_GROUP)
    A = -jnp.exp(A_log.astype(jnp.float32)).reshape(SSM_GROUPS, SSM_HEADS_PER_GROUP)
    y = ssd_chunked_scan(xs, dt, A, Bm, Cm)
    y = y + D_skip.reshape(SSM_GROUPS, SSM_HEADS_PER_GROUP)[..., None] * xs
    y = y.reshape(b, s, D_INNER).astype(h.dtype)
    gf = (y * jax.nn.silu(z)).astype(jnp.float32).reshape(b, s, SSM_GROUPS, D_INNER // SSM_GROUPS)
    gf = gf * lax.rsqrt(jnp.mean(gf * gf, axis=-1, keepdims=True) + GATED_NORM_EPS)
    y = gf.reshape(b, s, D_INNER).astype(h.dtype) * gnorm_w
    return y @ w_out


def fox_shared_kv(h, kv_norm, w_kvf, b_f):
    b, s, _ = h.shape
    kvf = rms_norm(h, kv_norm) @ w_kvf
    k = kvf[..., :ATT_DIM].reshape(b, s, FOX_HEADS, FOX_HEAD_DIM)
    v = kvf[..., ATT_DIM:2 * ATT_DIM].reshape(b, s, FOX_HEADS, FOX_HEAD_DIM)
    log_f = jax.nn.log_sigmoid(kvf[..., 2 * ATT_DIM:].astype(jnp.float32) + b_f.astype(jnp.float32))
    cum = jnp.cumsum(log_f, axis=1)
    return k, v, cum


def fox_attention(h, norm_w, w_q, w_o, k, v, cum):
    b, s, _ = h.shape
    nb = s // FOX_Q_BLOCK
    q = (rms_norm(h, norm_w) @ w_q).reshape(b, nb, FOX_Q_BLOCK, FOX_HEADS, FOX_HEAD_DIM)
    q = jnp.moveaxis(q, 1, 0)
    cq = jnp.moveaxis(cum.reshape(b, nb, FOX_Q_BLOCK, FOX_HEADS), 1, 0)
    qpos = jnp.arange(s, dtype=jnp.int32).reshape(nb, FOX_Q_BLOCK)
    kpos = jnp.arange(s, dtype=jnp.int32)
    ck = jnp.transpose(cum, (0, 2, 1))[:, :, None, :]

    def block(args):
        qi, ci, pi = args
        logits = jnp.einsum('bqhd,bkhd->bhqk', qi, k).astype(jnp.float32) * FOX_SCALE
        logits = logits + jnp.transpose(ci, (0, 2, 1))[..., None] - ck
        logits = jnp.where(kpos[None, :] <= pi[:, None], logits, -jnp.inf)
        probs = jax.nn.softmax(logits, axis=-1).astype(v.dtype)
        return jnp.einsum('bhqk,bkhd->bqhd', probs, v)

    o = lax.map(block, (q, cq, qpos))
    o = jnp.moveaxis(o, 0, 1).reshape(b, s, ATT_DIM)
    return o @ w_o


def peer_ffn(h, norm_w, w_q, sub_keys, u_tab, v_tab):
    b, s, d = h.shape
    xn = rms_norm(h, norm_w)
    q = (xn @ w_q).reshape(b, s, PEER_HEADS, 2, PEER_HALF)
    sc = jnp.einsum('bshcd,hckd->bshck', q, sub_keys).astype(jnp.float32)
    s1, i1 = lax.top_k(sc[..., 0, :], PEER_TOPK)
    s2, i2 = lax.top_k(sc[..., 1, :], PEER_TOPK)
    cand = (s1[..., :, None] + s2[..., None, :]).reshape(b, s, PEER_HEADS, PEER_TOPK * PEER_TOPK)
    cidx = (i1[..., :, None] * PEER_N_KEYS + i2[..., None, :]).reshape(b, s, PEER_HEADS, PEER_TOPK * PEER_TOPK)
    top, sel = lax.top_k(cand, PEER_TOPK)
    eidx = jnp.take_along_axis(cidx, sel, axis=-1)
    gates = jax.nn.softmax(top, axis=-1).astype(h.dtype)
    nblk = (b * s) // PEER_TOKEN_BLOCK
    n_sel = PEER_HEADS * PEER_TOPK
    xb = xn.reshape(nblk, PEER_TOKEN_BLOCK, d)
    ib = eidx.reshape(nblk, PEER_TOKEN_BLOCK, n_sel)
    gb = gates.reshape(nblk, PEER_TOKEN_BLOCK, n_sel)

    def block(args):
        xt, it, gt = args
        act = jax.nn.gelu(jnp.einsum('td,ted->te', xt, u_tab[it]), approximate=False)
        return jnp.einsum('te,ted->td', gt * act, v_tab[it])

    y = lax.map(block, (xb, ib, gb))
    return y.reshape(b, s, d)


def per_layer_embedding(h, p_i, norm_w, w_gate, b_gate, w_proj):
    gate = jax.nn.sigmoid(rms_norm(h, norm_w) @ w_gate + b_gate)
    return gate * (p_i @ w_proj)


def setup_inputs(seed: int = 0) -> dict:
    key = jax.random.key(seed)
    ks = jax.random.split(key, 28)
    f32 = jnp.float32
    nrm = lambda k, shape, scale: jax.random.normal(k, shape, f32) * scale
    gain = lambda k, shape: 1.0 + 0.02 * jax.random.normal(k, shape, f32)
    dt0 = jnp.exp(jax.random.uniform(ks[6], (N_A_LAYERS, SSM_HEADS), f32, np.log(1e-3), np.log(1e-1)))
    return {
        'x': nrm(ks[0], (BATCH, SEQ, D_MODEL), 1.0),
        'p': nrm(ks[1], (DEPTH, BATCH, SEQ, PLE_DIM), 1.0),
        'a_norm': gain(ks[2], (N_A_LAYERS, D_MODEL)),
        'a_in_proj': nrm(ks[3], (N_A_LAYERS, D_MODEL, D_IN_PROJ), D_MODEL ** -0.5),
        'a_conv_w': nrm(ks[4], (N_A_LAYERS, D_CONV, CONV_DIM), D_CONV ** -0.5),
        'a_conv_b': nrm(ks[5], (N_A_LAYERS, CONV_DIM), 0.02),
        'a_dt_bias': dt0 + jnp.log(-jnp.expm1(-dt0)),
        'a_A_log': jnp.log(jax.random.uniform(ks[7], (N_A_LAYERS, SSM_HEADS), f32, 1.0, 16.0)),
        'a_D': 1.0 + 0.1 * jax.random.normal(ks[8], (N_A_LAYERS, SSM_HEADS), f32),
        'a_gnorm': gain(ks[9], (N_A_LAYERS, D_INNER)),
        'a_out_proj': nrm(ks[10], (N_A_LAYERS, D_INNER, D_MODEL), D_INNER ** -0.5),
        'kv_norm': gain(ks[11], (D_MODEL,)),
        'w_kvf': nrm(ks[12], (D_MODEL, 2 * ATT_DIM + FOX_HEADS), D_MODEL ** -0.5),
        'b_f': jax.random.uniform(ks[13], (FOX_HEADS,), f32, 1.0, 6.0),
        'b_norm': gain(ks[14], (N_B_LAYERS, D_MODEL)),
        'b_wq': nrm(ks[15], (N_B_LAYERS, D_MODEL, ATT_DIM), D_MODEL ** -0.5),
        'b_wo': nrm(ks[16], (N_B_LAYERS, ATT_DIM, D_MODEL), ATT_DIM ** -0.5),
        'c_norm': gain(ks[17], (DEPTH, D_MODEL)),
        'c_wq': nrm(ks[18], (DEPTH, D_MODEL, PEER_HEADS * PEER_QUERY_DIM), D_MODEL ** -0.5),
        'c_subkeys': nrm(ks[19], (DEPTH, PEER_HEADS, 2, PEER_N_KEYS, PEER_HALF), PEER_HALF ** -0.5),
        'c_u': nrm(ks[20], (DEPTH, PEER_EXPERTS, D_MODEL), D_MODEL ** -0.5),
        'c_v': nrm(ks[21], (DEPTH, PEER_EXPERTS, D_MODEL), PEER_HEADS ** -0.5),
        'e_norm': gain(ks[22], (DEPTH, D_MODEL)),
        'e_wg': nrm(ks[23], (DEPTH, D_MODEL, D_MODEL), D_MODEL ** -0.5),
        'e_bg': nrm(ks[24], (DEPTH, D_MODEL), 0.02),
        'e_wp': nrm(ks[25], (DEPTH, PLE_DIM, D_MODEL), PLE_DIM ** -0.5),
        'f_norm': gain(ks[26], (D_MODEL,)),
    }


def reference(x, p, a_norm, a_in_proj, a_conv_w, a_conv_b, a_dt_bias, a_A_log, a_D, a_gnorm, a_out_proj,
              kv_norm, w_kvf, b_f, b_norm, b_wq, b_wo,
              c_norm, c_wq, c_subkeys, c_u, c_v,
              e_norm, e_wg, e_bg, e_wp, f_norm):
    h = x
    shared = None
    for i in range(DEPTH):
        if i < N_A_LAYERS:
            h = h + mamba2_mixer(h, a_norm[i], a_in_proj[i], a_conv_w[i], a_conv_b[i], a_dt_bias[i],
                                 a_A_log[i], a_D[i], a_gnorm[i], a_out_proj[i])
        else:
            j = i - N_A_LAYERS
            k, v, cum = shared
            h = h + fox_attention(h, b_norm[j], b_wq[j], b_wo[j], k, v, cum)
        h = h + peer_ffn(h, c_norm[i], c_wq[i], c_subkeys[i], c_u[i], c_v[i])
        h = h + per_layer_embedding(h, p[i], e_norm[i], e_wg[i], e_bg[i], e_wp[i])
        if i == N_A_LAYERS - 1:
            shared = fox_shared_kv(h, kv_norm, w_kvf, b_f)
    return rms_norm(h, f_norm)
```

```cpp
#include <hip/hip_runtime.h>
#include <hip/hip_bf16.h>
#include <hip/hip_cooperative_groups.h>
#include <cstdio>
#include <cstdint>
#include <cmath>
namespace cg = cooperative_groups;

#ifndef DBG_SKIP
#define DBG_SKIP 0
#endif
#ifndef DBG_BRUTE
#define DBG_BRUTE 0
#endif
#ifndef DBG_F32TAB
#define DBG_F32TAB 0
#endif
#ifndef DBG_SCORES
#define DBG_SCORES 0
#endif
#ifndef DBG_LIGHT
#define DBG_LIGHT 0
#endif
#ifndef DBG_S3MODE
#define DBG_S3MODE 0
#endif
#ifndef DBG_EMASK
#define DBG_EMASK 0xFFFFFF
#endif
#ifndef DBG_NREP
#define DBG_NREP 1
#endif
#ifndef DBG_REPEAT
#define DBG_REPEAT (-1)
#endif
#ifndef MK_PER_PHASE
#define MK_PER_PHASE 0
#endif

constexpr int SEQ = 8192, DM = 2048, DI = 4096, NHS = 64, HP = 64, NG = 8, NST = 128, CONVD = 6144, DINP = 10304, DINP_PAD = 10496;
constexpr int CHK = 256, NCH = SEQ / CHK;
constexpr int FH = 16, FD = 128;
constexpr int PH = 8, NKEY = 128, TOPK = 16, NEXP = 16384, PLE = 256;
constexpr float RMS_EPS = 1e-6f, GN_EPS = 1e-5f;
constexpr float LOG2E = 1.4426950408889634f;

constexpr size_t MiB = 1u << 20;
constexpr size_t WS_CTL = 0, CTL_ZERO_BYTES = 1 * MiB;
constexpr size_t WS_WIN = 1 * MiB;
constexpr size_t WS_WOUT = 42 * MiB;
constexpr size_t WS_WKV = 58 * MiB;
constexpr size_t WS_WQ = 74 * MiB;
constexpr size_t WS_WO = 82 * MiB;
constexpr size_t WS_WCQ = 90 * MiB;
constexpr size_t WS_WEG = 106 * MiB;
constexpr size_t WS_WEP = 122 * MiB;
constexpr size_t WS_SK = 124 * MiB;
constexpr size_t WS_PBF = 125 * MiB;
constexpr size_t WS_PP = 133 * MiB;
constexpr size_t WS_H = 197 * MiB;
constexpr size_t WS_XN = 261 * MiB;
constexpr size_t WS_SMALL = 293 * MiB;
constexpr size_t WS_DT = WS_SMALL, WS_ACL = WS_SMALL + 2 * MiB, WS_LOGF = WS_SMALL + 4 * MiB, WS_NB = WS_SMALL + 5 * MiB;
constexpr size_t WS_OV = 300 * MiB;
constexpr size_t WS_Z = WS_OV;
constexpr size_t WS_XBC = WS_OV + 64 * MiB;
constexpr size_t WS_Y = WS_XBC;
constexpr size_t WS_XBCC = WS_OV + 160 * MiB;
constexpr size_t WS_SLOC = WS_OV + 256 * MiB;
constexpr size_t WS_SIN = WS_OV + 320 * MiB;
constexpr size_t WS_Q = WS_OV, WS_K = WS_OV + 32 * MiB, WS_V = WS_OV + 64 * MiB, WS_O = WS_OV + 96 * MiB;
constexpr size_t WS_PQ = WS_OV + 128 * MiB;
constexpr size_t WS_TAB = WS_OV + 160 * MiB;
constexpr size_t WS_TSC = WS_OV + 288 * MiB;
constexpr size_t WS_XN2 = WS_OV + 416 * MiB;
constexpr size_t WS_EIDX = WS_OV + 448 * MiB;
constexpr size_t WS_GATE = WS_OV + 452 * MiB;
constexpr size_t WS_SUE = WS_OV + 456 * MiB;
constexpr size_t WS_OP = WS_OV + 460 * MiB;
constexpr size_t WS_ML = WS_OV + 524 * MiB;
constexpr size_t WS_END = WS_OV + 526 * MiB;

constexpr int CW_TMO = 0, CW_CODE = 1, CW_BAR = 4096, CW_NORM = 8192, CW_TICKET = 8320, CW_ROWSS = 32768, CW_FINSS = 65536, CW_FINCNT = 81920;
constexpr float SS_FIX = 4096.f;

#define GAS __attribute__((address_space(1)))
#define LAS __attribute__((address_space(3)))
typedef unsigned short bf16;
typedef unsigned v4u __attribute__((ext_vector_type(4)));
typedef unsigned v2u __attribute__((ext_vector_type(2)));
typedef float f32x4 __attribute__((ext_vector_type(4)));
typedef float f32x2_t __attribute__((ext_vector_type(2)));
typedef float f32x16 __attribute__((ext_vector_type(16)));
typedef short bf16x8 __attribute__((ext_vector_type(8)));
typedef short s16x4 __attribute__((ext_vector_type(4)));
typedef __bf16 bf16x2_t __attribute__((ext_vector_type(2)));
typedef GAS unsigned gu32;
#define RLX_AGENT __ATOMIC_RELAXED, __HIP_MEMORY_SCOPE_AGENT
#define LDS_WAIT() asm volatile("s_waitcnt lgkmcnt(0)" ::: "memory")
#define VM_WAIT() asm volatile("s_waitcnt vmcnt(0)" ::: "memory")
#define SBAR() __builtin_amdgcn_sched_barrier(0)

__device__ __forceinline__ unsigned cvtpk(float lo, float hi) { f32x2_t v = {lo, hi}; bf16x2_t b = __builtin_convertvector(v, bf16x2_t); return __builtin_bit_cast(unsigned, b); }
__device__ __forceinline__ float bflo(unsigned u) { return __builtin_bit_cast(float, u << 16); }
__device__ __forceinline__ float bfhi(unsigned u) { return __builtin_bit_cast(float, u & 0xffff0000u); }
#define DPP_F(v, ctrl) __builtin_bit_cast(float, __builtin_amdgcn_update_dpp(__builtin_bit_cast(int, v), __builtin_bit_cast(int, v), ctrl, 0xF, 0xF, false))
__device__ __forceinline__ float wave_sum(float v) {
    v += DPP_F(v, 0xB1); v += DPP_F(v, 0x4E); v += DPP_F(v, 0x141); v += DPP_F(v, 0x140);
    const float a = __builtin_bit_cast(float, __builtin_amdgcn_readlane(__builtin_bit_cast(int, v), 0)), b = __builtin_bit_cast(float, __builtin_amdgcn_readlane(__builtin_bit_cast(int, v), 16));
    const float c = __builtin_bit_cast(float, __builtin_amdgcn_readlane(__builtin_bit_cast(int, v), 32)), d = __builtin_bit_cast(float, __builtin_amdgcn_readlane(__builtin_bit_cast(int, v), 48));
    return (a + b) + (c + d);
}
__device__ __forceinline__ float wave_max(float v) {
    v = fmaxf(v, DPP_F(v, 0xB1)); v = fmaxf(v, DPP_F(v, 0x4E)); v = fmaxf(v, DPP_F(v, 0x141)); v = fmaxf(v, DPP_F(v, 0x140));
    const float a = __builtin_bit_cast(float, __builtin_amdgcn_readlane(__builtin_bit_cast(int, v), 0)), b = __builtin_bit_cast(float, __builtin_amdgcn_readlane(__builtin_bit_cast(int, v), 16));
    const float c = __builtin_bit_cast(float, __builtin_amdgcn_readlane(__builtin_bit_cast(int, v), 32)), d = __builtin_bit_cast(float, __builtin_amdgcn_readlane(__builtin_bit_cast(int, v), 48));
    return fmaxf(fmaxf(a, b), fmaxf(c, d));
}
__device__ __forceinline__ float ss_rstd(unsigned long long s) { return 1.f / sqrtf((float)s * (1.f / (SS_FIX * 2048.f)) + 1e-6f); }
__device__ __forceinline__ float sigmoidf_(float x) { return 1.f / (1.f + __expf(-x)); }
__device__ __forceinline__ float siluf_(float x) { return x / (1.f + __expf(-x)); }
namespace pg8 {
#define PG8_LAS __attribute__((address_space(3)))
typedef unsigned short bf16_t;
typedef short bf16x8 __attribute__((ext_vector_type(8)));
typedef float f32x4 __attribute__((ext_vector_type(4)));
typedef unsigned u32x4 __attribute__((ext_vector_type(4)));
constexpr int BM = 256, BK = 64, HALF = 128, HTB = HALF * BK * 2  , STAGE_BYTES = 8 * HTB, NXCD = 8, WGM = 8;

__host__ __device__ __forceinline__ int lds_byte(int r, int c) { const int st = (r >> 4) * 2 + (c >> 5), rr = r & 15, cc = c & 31, ob = rr * 64 + cc * 2; return st * 1024 + (ob ^ (((ob >> 9) & 1) << 5)); }
__host__ __device__ __forceinline__ void stage_rc(int b, int& R, int& C) { const int st = b / 1024, sb = b % 1024, swz = sb ^ (((sb >> 9) & 1) << 5); R = (st >> 1) * 16 + swz / 64; C = (st & 1) * 32 + (swz % 64) / 2; }
__host__ __device__ __forceinline__ int perm32(int rho) { const int n = rho >> 4, i = rho & 15; return 8 * (i >> 2) + 4 * n + (i & 3); }

struct Unit { int pm, pn; };
struct Gemm { const bf16_t* A; const bf16_t* Bt; int M, N, K; };

struct StaticOrder {
    int nM, nN, nwg, G, c;
    __host__ __device__ void init(int M, int N, int G_, int c_) { nM = M / BM; nN = N / BM; nwg = nM * nN; G = G_; c = c_; }
    __host__ __device__ bool next(int i, Unit& u) const {
        const long L = (long)i * G + c; if (L >= nwg) return false;
        int wgid = (int)L; { const int q = nwg / NXCD, r = nwg % NXCD, xcd = wgid % NXCD, off = wgid / NXCD; wgid = (xcd < r ? xcd * (q + 1) : r * (q + 1) + (xcd - r) * q) + off; }
        const int nig = WGM * nN, gid = wgid / nig, fm = gid * WGM, gsz = (nM - fm) < WGM ? (nM - fm) : WGM;
        u.pm = fm + ((wgid % nig) % gsz); u.pn = (wgid % nig) / gsz; return true;
    }
    __device__ __forceinline__ void a_ready(const Unit&) const {}
    __device__ __forceinline__ void done(const Unit&) const {}
};

enum { EP_INPROJ = 0, EP_BF16 = 1, EP_KV = 2, EP_RESX = 3, EP_RESH = 4, EP_PLE = 5, EP_BF16S = 6 };
template <int MODE> struct EpiG {
    static constexpr bool PERM = true, AFTER_DRAIN = false;
    bf16_t* o0; bf16_t* o1; float* f0; const float* c0; const bf16_t* b0; int ldc; const float* w1; unsigned long long* ss;
    __device__ __forceinline__ static u32x4 pack8(f32x4 a, f32x4 b) { u32x4 w; w.x = ::cvtpk(a[0], a[1]); w.y = ::cvtpk(a[2], a[3]); w.z = ::cvtpk(b[0], b[1]); w.w = ::cvtpk(b[2], b[3]); return w; }
    __device__ __forceinline__ void emit(int row, int col, f32x4 v0, f32x4 v1) const {
        if constexpr (MODE == EP_INPROJ) {
        } else if constexpr (MODE == EP_BF16) {
            *(u32x4*)(o0 + (size_t)row * ldc + col) = pack8(v0, v1);
        } else if constexpr (MODE == EP_KV) {
            if (col < 2048) *(u32x4*)(o0 + (size_t)row * 2048 + col) = pack8(v0, v1);
            else *(u32x4*)(o1 + (size_t)row * 2048 + (col - 2048)) = pack8(v0, v1);
        } else if constexpr (MODE == EP_PLE) {
            if (ldc) return;
            const size_t off = (size_t)row * 2048 + col; const f32x4 a = *(const f32x4*)(f0 + off), b = *(const f32x4*)(f0 + off + 4);
            const f32x4 g0 = *(const f32x4*)(c0 + col), g1 = *(const f32x4*)(c0 + col + 4); const u32x4 pw = *(const u32x4*)(b0 + off);
            f32x4 r0, r1;
            r0[0] = a[0] + ::sigmoidf_(v0[0] + g0[0]) * ::bflo(pw.x); r0[1] = a[1] + ::sigmoidf_(v0[1] + g0[1]) * ::bfhi(pw.x);
            r0[2] = a[2] + ::sigmoidf_(v0[2] + g0[2]) * ::bflo(pw.y); r0[3] = a[3] + ::sigmoidf_(v0[3] + g0[3]) * ::bfhi(pw.y);
            r1[0] = b[0] + ::sigmoidf_(v1[0] + g1[0]) * ::bflo(pw.z); r1[1] = b[1] + ::sigmoidf_(v1[1] + g1[1]) * ::bfhi(pw.z);
            r1[2] = b[2] + ::sigmoidf_(v1[2] + g1[2]) * ::bflo(pw.w); r1[3] = b[3] + ::sigmoidf_(v1[3] + g1[3]) * ::bfhi(pw.w);
            *(f32x4*)(f0 + off) = r0; *(f32x4*)(f0 + off + 4) = r1;
        }
    }
    __device__ __forceinline__ void operator()(const f32x4 (&acc)[2][2][4][2], const Unit& u, int wr, int wc, int fr, int fq) const {
        const int row0 = u.pm * BM + wr * 64 + fr, colb = u.pn * BM + wc * 32 + 8 * fq;
        if constexpr (MODE == EP_INPROJ) {
            if (u.pn < 40) {
                bf16_t* base; int ld, c0_;
                if (u.pn < 16) { base = o0; ld = 4096; c0_ = colb; } else { base = o1; ld = 6144; c0_ = colb - 4096; }
#pragma unroll
                for (int ai = 0; ai < 2; ++ai)
#pragma unroll
                    for (int m = 0; m < 4; ++m) { bf16_t* rp = base + (size_t)(row0 + ai * HALF + m * 16) * ld + c0_;
#pragma unroll
                        for (int bj = 0; bj < 2; ++bj) *(u32x4*)(rp + bj * HALF) = pack8(acc[ai][bj][m][0], acc[ai][bj][m][1]); }
            } else if (wc < 2) {
                const int c = wc * 32 + 8 * fq;
#pragma unroll
                for (int ai = 0; ai < 2; ++ai)
#pragma unroll
                    for (int m = 0; m < 4; ++m) { float* rp = f0 + (size_t)(row0 + ai * HALF + m * 16) * 64 + c; *(f32x4*)rp = acc[ai][0][m][0]; *(f32x4*)(rp + 4) = acc[ai][0][m][1]; }
            }
        } else if constexpr (MODE == EP_RESX || MODE == EP_RESH) {
            if (MODE == EP_RESH && ldc) return;
            f32x4 wv[2][2];
#pragma unroll
            for (int bj = 0; bj < 2; ++bj) { wv[bj][0] = *(const f32x4*)(w1 + colb + bj * HALF); wv[bj][1] = *(const f32x4*)(w1 + colb + bj * HALF + 4); }
            const float* R = MODE == EP_RESX ? c0 : f0;
#pragma unroll
            for (int ai = 0; ai < 2; ++ai)
#pragma unroll
                for (int m = 0; m < 4; ++m) { const int row = row0 + ai * HALF + m * 16; float sq = 0.f;
#pragma unroll
                    for (int bj = 0; bj < 2; ++bj) { const size_t off = (size_t)row * 2048 + colb + bj * HALF;
                        f32x4 v0 = acc[ai][bj][m][0], v1 = acc[ai][bj][m][1];
                        if (MODE == EP_RESX && ldc) { v0 = v0 * 0.f; v1 = v1 * 0.f; }
                        const f32x4 r0 = *(const f32x4*)(R + off) + v0, r1 = *(const f32x4*)(R + off + 4) + v1;
                        *(f32x4*)(f0 + off) = r0; *(f32x4*)(f0 + off + 4) = r1;
                        sq += (r0[0] * r0[0] + r0[1] * r0[1]) + (r0[2] * r0[2] + r0[3] * r0[3]) + (r1[0] * r1[0] + r1[1] * r1[1]) + (r1[2] * r1[2] + r1[3] * r1[3]);
                        *(u32x4*)(o0 + off) = pack8(r0 * wv[bj][0], r1 * wv[bj][1]); }
                    sq += __shfl_xor(sq, 16); sq += __shfl_xor(sq, 32);
                    if (fq == 0) atomicAdd(ss + row, (unsigned long long)(unsigned)(sq * ::SS_FIX)); }
        } else if constexpr (MODE == EP_BF16S) {
#pragma unroll
            for (int ai = 0; ai < 2; ++ai)
#pragma unroll
                for (int m = 0; m < 4; ++m) { const int row = row0 + ai * HALF + m * 16;
                    const float rs = ::ss_rstd(ss[row]);
#pragma unroll
                    for (int bj = 0; bj < 2; ++bj) *(u32x4*)(o0 + (size_t)row * ldc + colb + bj * HALF) = pack8(acc[ai][bj][m][0] * rs, acc[ai][bj][m][1] * rs); }
        } else {
#pragma unroll
        for (int ai = 0; ai < 2; ++ai)
#pragma unroll
            for (int m = 0; m < 4; ++m)
#pragma unroll
                for (int bj = 0; bj < 2; ++bj) emit(row0 + ai * HALF + m * 16, colb + bj * HALF, acc[ai][bj][m][0], acc[ai][bj][m][1]);
        }
    }
};

struct EpiFin {
    static constexpr bool PERM = true, AFTER_DRAIN = true;
    const float* H; const float* gb; const bf16_t* pp; const float* fw; unsigned long long* ss; unsigned* cnt; float* out; int dry;
    template <class LDS>
    __device__ __forceinline__ void fused(f32x4 (&acc)[2][2][4][2], const Unit& u, int wr, int wc, int fr_, int fq_, LDS, int, int lane_) const {
        if (dry) return;
        int le = lane_; asm volatile("" : "+v"(le)); const int fr = le & 15, fq = le >> 4; (void)fr_; (void)fq_;
        const int row0 = u.pm * BM + wr * 64 + fr, colb = u.pn * BM + wc * 32 + 8 * fq;
#pragma unroll
        for (int bj = 0; bj < 2; ++bj) { const int col = colb + bj * HALF; const f32x4 g0 = *(const f32x4*)(gb + col), g1 = *(const f32x4*)(gb + col + 4);
#pragma unroll
            for (int ai = 0; ai < 2; ++ai)
#pragma unroll
                for (int m = 0; m < 4; ++m) { const unsigned eo = (unsigned)(row0 + ai * HALF + m * 16) * 2048u + (unsigned)col;
                    const f32x4 a = *(const f32x4*)((const char*)H + eo * 4u), b = *(const f32x4*)((const char*)H + eo * 4u + 16u); const u32x4 pw = *(const u32x4*)((const char*)pp + eo * 2u); const f32x4 v0 = acc[ai][bj][m][0], v1 = acc[ai][bj][m][1];
                    f32x4 r0, r1;
                    r0[0] = a[0] + ::sigmoidf_(v0[0] + g0[0]) * ::bflo(pw.x); r0[1] = a[1] + ::sigmoidf_(v0[1] + g0[1]) * ::bfhi(pw.x);
                    r0[2] = a[2] + ::sigmoidf_(v0[2] + g0[2]) * ::bflo(pw.y); r0[3] = a[3] + ::sigmoidf_(v0[3] + g0[3]) * ::bfhi(pw.y);
                    r1[0] = b[0] + ::sigmoidf_(v1[0] + g1[0]) * ::bflo(pw.z); r1[1] = b[1] + ::sigmoidf_(v1[1] + g1[1]) * ::bfhi(pw.z);
                    r1[2] = b[2] + ::sigmoidf_(v1[2] + g1[2]) * ::bflo(pw.w); r1[3] = b[3] + ::sigmoidf_(v1[3] + g1[3]) * ::bfhi(pw.w);
                    acc[ai][bj][m][0] = r0; acc[ai][bj][m][1] = r1;
                    if (m == 3) asm volatile("" : "+v"(acc[ai][bj][0][0]), "+v"(acc[ai][bj][0][1]), "+v"(acc[ai][bj][1][0]), "+v"(acc[ai][bj][1][1]), "+v"(acc[ai][bj][2][0]), "+v"(acc[ai][bj][2][1]), "+v"(acc[ai][bj][3][0]), "+v"(acc[ai][bj][3][1]) :: "memory"); } }
#pragma unroll
        for (int ai = 0; ai < 2; ++ai)
#pragma unroll
            for (int m = 0; m < 4; ++m) { float sq = 0.f;
#pragma unroll
                for (int bj = 0; bj < 2; ++bj) { const f32x4 r0 = acc[ai][bj][m][0], r1 = acc[ai][bj][m][1];
                    sq += (r0[0] * r0[0] + r0[1] * r0[1]) + (r0[2] * r0[2] + r0[3] * r0[3]) + (r1[0] * r1[0] + r1[1] * r1[1]) + (r1[2] * r1[2] + r1[3] * r1[3]); }
                sq += __shfl_xor(sq, 16); sq += __shfl_xor(sq, 32);
                if (fq == 0) { const unsigned long long o_ = atomicAdd(ss + row0 + ai * HALF + m * 16, (unsigned long long)(unsigned)(sq * ::SS_FIX)); asm volatile("" :: "v"(o_)); } }
        asm volatile("s_waitcnt vmcnt(0)" ::: "memory");
        __syncthreads();
        if (le == 0 && wr == 0 && wc == 0) {
            __hip_atomic_fetch_add(cnt + u.pm, 1u, __ATOMIC_RELAXED, __HIP_MEMORY_SCOPE_AGENT);
            unsigned sp = 0; while (__hip_atomic_load(cnt + u.pm, __ATOMIC_RELAXED, __HIP_MEMORY_SCOPE_AGENT) < 8u) { __builtin_amdgcn_s_sleep(1); if (++sp > (1u << 24)) break; }
        }
        __syncthreads();
#pragma unroll
        for (int bj = 0; bj < 2; ++bj) { const int col = colb + bj * HALF; const f32x4 w0 = *(const f32x4*)(fw + col), w1_ = *(const f32x4*)(fw + col + 4);
#pragma unroll
            for (int ai = 0; ai < 2; ++ai)
#pragma unroll
                for (int m = 0; m < 4; ++m) { const int row = row0 + ai * HALF + m * 16; const float rs = ::ss_rstd(__hip_atomic_load(ss + row, __ATOMIC_RELAXED, __HIP_MEMORY_SCOPE_AGENT));
                    float* op = out + (size_t)row * 2048 + col; *(f32x4*)op = acc[ai][bj][m][0] * rs * w0; *(f32x4*)(op + 4) = acc[ai][bj][m][1] * rs * w1_; } }
    }
};
template <class Epi, class Sched, bool ALIGN_EPI = false, bool SP2 = false, bool FP8 = false>
__device__ __forceinline__ void gemm_phase(PG8_LAS unsigned char* lds, const Gemm g, const Sched& S, const Epi& E, const int tid) {
    const int wid = __builtin_amdgcn_readfirstlane(tid >> 6), lane = tid & 63, wr = wid >> 2, wc = wid & 3, fr = lane & 15, fq = lane >> 4;
    const int K = g.K, nt = FP8 ? K / (2 * BK) : K / BK;
    unsigned voffA[2], voffB[2];
#pragma unroll
    for (int i = 0; i < 2; ++i) { int R, C; stage_rc(tid * 16 + i * 8192, R, C); const int Rb = Epi::PERM ? ((R & ~31) + perm32(R & 31)) : R;
        voffA[i] = FP8 ? (unsigned)(R * K + C * 2) : (unsigned)(R * K + C) * 2u; voffB[i] = FP8 ? (unsigned)(Rb * K + C * 2) : (unsigned)(Rb * K + C) * 2u; }
    const size_t kstep = (size_t)(BK * 2);
    const size_t hstep = (size_t)HALF * K * (FP8 ? 1 : 2);
    const size_t tstep = 2 * hstep;
    const unsigned ldsw = (unsigned)wid * 1024u;
    const int aoff = lds_byte(wr * 64 + fr, fq * 8), boff = lds_byte(wc * 32 + fr, fq * 8);
typedef int pg8_i32x8 __attribute__((ext_vector_type(8)));
#define PG8_CAT(x, y) __builtin_bit_cast(pg8_i32x8, __builtin_shufflevector(x, y, 0, 1, 2, 3, 4, 5, 6, 7, 8, 9, 10, 11, 12, 13, 14, 15))
#define PG8_SA(b, h) (((b) * 2 + (h)) * HTB)
#define PG8_SB(b, h) ((4 + (b) * 2 + (h)) * HTB)
#define PG8_STAGE(bufoff, gbase, voff) do { _Pragma("unroll") for (int _i = 0; _i < 2; ++_i) \
        __builtin_amdgcn_global_load_lds((const unsigned*)((const char*)(gbase) + (voff)[_i]), (PG8_LAS unsigned*)(lds + (bufoff) + ldsw + _i * 8192), 16, 0, 0); } while (0)
#define PG8_LDA(dst, b, h) do { if constexpr (FP8) { _Pragma("unroll") for (int m = 0; m < 4; ++m) dst##8[m] = PG8_CAT(*(const PG8_LAS bf16x8*)(lds + PG8_SA(b, h) + aoff + m * 2048), *(const PG8_LAS bf16x8*)(lds + PG8_SA(b, h) + aoff + m * 2048 + 1024)); } \
    else { _Pragma("unroll") for (int m = 0; m < 4; ++m) _Pragma("unroll") for (int k = 0; k < 2; ++k) dst[m][k] = *(const PG8_LAS bf16x8*)(lds + PG8_SA(b, h) + aoff + m * 2048 + k * 1024); } } while (0)
#define PG8_LDB(dst, b, h) do { if constexpr (FP8) { _Pragma("unroll") for (int n = 0; n < 2; ++n) dst##8[n] = PG8_CAT(*(const PG8_LAS bf16x8*)(lds + PG8_SB(b, h) + boff + n * 2048), *(const PG8_LAS bf16x8*)(lds + PG8_SB(b, h) + boff + n * 2048 + 1024)); } \
    else { _Pragma("unroll") for (int n = 0; n < 2; ++n) _Pragma("unroll") for (int k = 0; k < 2; ++k) dst[n][k] = *(const PG8_LAS bf16x8*)(lds + PG8_SB(b, h) + boff + n * 2048 + k * 1024); } } while (0)
#define PG8_MMA(ai, bj, At, Bt) do { __builtin_amdgcn_s_setprio(1); \
        if constexpr (FP8) { asm volatile("s_nop 1"); _Pragma("unroll") for (int m = 0; m < 4; ++m) _Pragma("unroll") for (int n = 0; n < 2; ++n) \
            asm volatile("v_mfma_scale_f32_16x16x128_f8f6f4 %0, %1, %2, %0, %3, %4 op_sel_hi:[0,0,0]" : "+v"(acc[ai][bj][m][n]) : "v"(Bt##8[n]), "v"(At##8[m]), "v"(sc_w), "v"(sc_a)); } \
        else { _Pragma("unroll") for (int m = 0; m < 4; ++m) _Pragma("unroll") for (int n = 0; n < 2; ++n) _Pragma("unroll") for (int k = 0; k < 2; ++k) \
            acc[ai][bj][m][n] = __builtin_amdgcn_mfma_f32_16x16x32_bf16(Bt[n][k], At[m][k], acc[ai][bj][m][n], 0, 0, 0); } \
        __builtin_amdgcn_s_setprio(0); } while (0)
#define PG8_WAIT_V(n) asm volatile("s_waitcnt vmcnt(" #n ")" ::: "memory")
#define PG8_WAIT_L(n) asm volatile("s_waitcnt lgkmcnt(" #n ")" ::: "memory")
#define PG8_BAR __builtin_amdgcn_s_barrier()
#define PG8_SCHED __builtin_amdgcn_sched_barrier(0)
    Unit cur, nxt; int ui = 0;
    if (!S.next(0, cur)) return;
    f32x4 acc[2][2][4][2];
#pragma unroll
    for (int a = 0; a < 2; ++a)
#pragma unroll
        for (int b = 0; b < 2; ++b)
#pragma unroll
            for (int m = 0; m < 4; ++m)
#pragma unroll
                for (int n = 0; n < 2; ++n) acc[a][b][m][n] = (f32x4){0.f, 0.f, 0.f, 0.f};
    bf16x8 At[4][2], B0[2][2], B1[2][2]; pg8_i32x8 At8[4], B08[2], B18[2];
    int sc_w = 0x79797979, sc_a = 0x7f7f7f7f; asm volatile("" : "+v"(sc_w), "+v"(sc_a));
    const char* cA = (const char*)g.A + (size_t)cur.pm * tstep; const char* cB = (const char*)g.Bt + (size_t)cur.pn * tstep;
    S.a_ready(cur);
    if constexpr (SP2) {
        PG8_STAGE(PG8_SB(0, 0), cB, voffB); PG8_STAGE(PG8_SB(0, 1), cB + hstep, voffB); PG8_STAGE(PG8_SA(0, 0), cA, voffA); PG8_STAGE(PG8_SA(0, 1), cA + hstep, voffA);
        if (wr == 1) PG8_BAR;
        PG8_WAIT_V(2); PG8_BAR;
        PG8_STAGE(PG8_SB(1, 0), cB + kstep, voffB); PG8_STAGE(PG8_SA(1, 0), cA + kstep, voffA); PG8_STAGE(PG8_SB(1, 1), cB + hstep + kstep, voffB);
        PG8_WAIT_V(6); PG8_BAR;
    } else {
        PG8_STAGE(PG8_SB(0, 0), cB, voffB); PG8_STAGE(PG8_SA(0, 0), cA, voffA); PG8_STAGE(PG8_SB(0, 1), cB + hstep, voffB); PG8_STAGE(PG8_SA(0, 1), cA + hstep, voffA);
        if (wr == 1) PG8_BAR;
        PG8_WAIT_V(4); PG8_BAR;
        PG8_STAGE(PG8_SB(1, 0), cB + kstep, voffB); PG8_STAGE(PG8_SA(1, 0), cA + kstep, voffA); PG8_STAGE(PG8_SB(1, 1), cB + hstep + kstep, voffB);
        PG8_WAIT_V(6); PG8_BAR;
    }
    for (;;) {
        const bool has_next = S.next(ui + 1, nxt);
        const char* nA = has_next ? (const char*)g.A + (size_t)nxt.pm * tstep : cA; const char* nB = has_next ? (const char*)g.Bt + (size_t)nxt.pn * tstep : cB;
        for (int t = 0; t < nt; t += 2) {
            const bool last = (t == nt - 2);
            const char* a1 = cA + (size_t)(t + 1) * kstep;
            const char* a2 = last ? nA : cA + (size_t)(t + 2) * kstep; const char* b2 = last ? nB : cB + (size_t)(t + 2) * kstep;
            const char* a3 = a2 + kstep; const char* b3 = b2 + kstep;
            if (last && has_next) S.a_ready(nxt);
            if constexpr (SP2) {
            PG8_LDB(B0, 0, 0); PG8_LDB(B1, 0, 1); PG8_SCHED; PG8_LDA(At, 0, 0); PG8_STAGE(PG8_SA(1, 1), a1 + hstep, voffA);
            PG8_WAIT_V(8); PG8_WAIT_L(0); PG8_BAR; PG8_MMA(0, 0, At, B0); PG8_MMA(0, 1, At, B1); PG8_BAR; PG8_SCHED;
            PG8_LDA(At, 0, 1); PG8_STAGE(PG8_SB(0, 0), b2, voffB); PG8_STAGE(PG8_SB(0, 1), b2 + hstep, voffB); PG8_STAGE(PG8_SA(0, 0), a2, voffA);
            PG8_WAIT_V(8); PG8_WAIT_L(0); PG8_BAR; PG8_MMA(1, 0, At, B0); PG8_MMA(1, 1, At, B1); PG8_BAR; PG8_SCHED;
            PG8_LDB(B0, 1, 0); PG8_LDB(B1, 1, 1); PG8_SCHED; PG8_LDA(At, 1, 0); PG8_STAGE(PG8_SA(0, 1), a2 + hstep, voffA);
            PG8_WAIT_V(8); PG8_WAIT_L(0); PG8_BAR; PG8_MMA(0, 0, At, B0); PG8_MMA(0, 1, At, B1); PG8_BAR; PG8_SCHED;
            PG8_LDA(At, 1, 1); PG8_STAGE(PG8_SB(1, 0), b3, voffB); PG8_STAGE(PG8_SB(1, 1), b3 + hstep, voffB); PG8_STAGE(PG8_SA(1, 0), a3, voffA);
            PG8_WAIT_V(8); PG8_WAIT_L(0); PG8_BAR; PG8_MMA(1, 0, At, B0); PG8_MMA(1, 1, At, B1); PG8_BAR; PG8_SCHED;
            } else {
            PG8_LDB(B0, 0, 0); PG8_SCHED; PG8_LDA(At, 0, 0); PG8_STAGE(PG8_SA(1, 1), a1 + hstep, voffA);
            PG8_WAIT_L(8); PG8_BAR; PG8_WAIT_L(0); PG8_MMA(0, 0, At, B0); PG8_BAR; PG8_SCHED;
            PG8_LDB(B1, 0, 1); PG8_STAGE(PG8_SB(0, 0), b2, voffB);
            PG8_BAR; PG8_WAIT_L(0); PG8_MMA(0, 1, At, B1); PG8_BAR;
            PG8_LDA(At, 0, 1); PG8_STAGE(PG8_SA(0, 0), a2, voffA);
            PG8_BAR; PG8_WAIT_L(0); PG8_MMA(1, 0, At, B0); PG8_BAR; PG8_SCHED;
            PG8_STAGE(PG8_SB(0, 1), b2 + hstep, voffB);
            PG8_WAIT_V(6); PG8_BAR; PG8_MMA(1, 1, At, B1); PG8_BAR;
            PG8_LDB(B0, 1, 0); PG8_SCHED; PG8_LDA(At, 1, 0); PG8_STAGE(PG8_SA(0, 1), a2 + hstep, voffA);
            PG8_WAIT_L(8); PG8_BAR; PG8_WAIT_L(0); PG8_MMA(0, 0, At, B0); PG8_BAR; PG8_SCHED;
            PG8_LDB(B1, 1, 1); PG8_STAGE(PG8_SB(1, 0), b3, voffB);
            PG8_BAR; PG8_WAIT_L(0); PG8_MMA(0, 1, At, B1); PG8_BAR;
            PG8_LDA(At, 1, 1); PG8_STAGE(PG8_SA(1, 0), a3, voffA);
            PG8_BAR; PG8_WAIT_L(0); PG8_MMA(1, 0, At, B0); PG8_BAR; PG8_SCHED;
            PG8_STAGE(PG8_SB(1, 1), b3 + hstep, voffB);
            PG8_WAIT_V(6); PG8_BAR; PG8_MMA(1, 1, At, B1); PG8_BAR;
            }
        }
        if constexpr (ALIGN_EPI) { if (wr == 0) PG8_BAR; }
        if constexpr (FP8) asm volatile("s_nop 15\n\ts_nop 7" ::: "memory");
        if constexpr (!Epi::AFTER_DRAIN) { int le_ = lane; asm volatile("" : "+v"(le_)); E(acc, cur, wr, wc, le_ & 15, le_ >> 4); S.done(cur); }
        if (!has_next) break;
#pragma unroll
        for (int a = 0; a < 2; ++a)
#pragma unroll
            for (int b = 0; b < 2; ++b)
#pragma unroll
                for (int m = 0; m < 4; ++m)
#pragma unroll
                    for (int n = 0; n < 2; ++n) acc[a][b][m][n] = (f32x4){0.f, 0.f, 0.f, 0.f};
        cur = nxt; cA = nA; cB = nB; ++ui;
        if constexpr (ALIGN_EPI) { if (wr == 1) PG8_BAR; }
    }
    PG8_WAIT_V(0);
    if constexpr (!ALIGN_EPI) { if (wr == 0) PG8_BAR; }
    PG8_BAR;
    if constexpr (Epi::AFTER_DRAIN) { E.fused(acc, cur, wr, wc, fr, fq, lds, wid, lane); S.done(cur); }
#undef PG8_SA
#undef PG8_CAT
#undef PG8_SB
#undef PG8_STAGE
#undef PG8_LDA
#undef PG8_LDB
#undef PG8_MMA
#undef PG8_WAIT_V
#undef PG8_WAIT_L
#undef PG8_BAR
#undef PG8_SCHED
}
}
namespace fox {
constexpr int D = 128, RS = 2048;
constexpr float SCALE = 0.08838834764831845f;
constexpr float THR = 8.f;
constexpr int NW = 8, QBLK = 32, KVBLK = 64, QB = NW * QBLK;
constexpr int SHM_V = KVBLK * D * 2, SHM_K = KVBLK * D * 2;
constexpr int LDS_BYTES = 2 * SHM_V + 2 * SHM_K + NW * 64 * 4;
#define KSWZ(row, colB) ((row) * 256 + ((colB) ^ (((row) & 7) << 4)))
__device__ __forceinline__ int v_st(int k, int c) { const int kk = (k & ~0xC) | ((k & 4) << 1) | ((k & 8) >> 1); return ((kk >> 3) * 4 + (c >> 5)) * 512 + ((kk & 7) * 32 + (c & 31)) * 2; }
__device__ __forceinline__ int v_rd_base(int lane) { return ((lane & 3) << 3) | (((lane >> 2) & 3) << 6) | (((lane >> 4) & 1) << 5) | (((lane >> 5) & 1) << 8); }
constexpr int v_rd_off(int d0, int ks, int half) { return d0 * 512 + ks * 4096 + half * 2048; }
__device__ __forceinline__ int crow(int r, int hi) { return (r & 3) + 8 * (r >> 2) + 4 * hi; }
__device__ __forceinline__ bf16x8 load8(const bf16* p) { return *reinterpret_cast<const bf16x8*>(p); }
__device__ __forceinline__ void mask_tile(f32x16& p0, f32x16& p1, int dq, unsigned W) {
    const float NEG = -__builtin_inff();
#pragma unroll
    for (int r = 0; r < 16; ++r) {
        const int c = (r & 3) + 8 * (r >> 2);
        if ((unsigned)(dq - c) >= W) p0[r] = NEG;
        if ((unsigned)(dq - c - 32) >= W) p1[r] = NEG;
    }
}
__device__ __forceinline__ void partialSM(f32x16& p0, f32x16& p1, float& m_reg, float& alpha) { float mn;
    float pmax = p0[0]; for (int r = 1; r < 16; ++r) pmax = fmaxf(pmax, p0[r]); for (int r = 0; r < 16; ++r) pmax = fmaxf(pmax, p1[r]);
    { auto rr = __builtin_amdgcn_permlane32_swap(__float_as_uint(pmax), __float_as_uint(pmax), false, false);
      pmax = fmaxf(__uint_as_float(rr[0]), __uint_as_float(rr[1])); }
    constexpr float C2 = 1.4426950408889634f * SCALE;
    if (__builtin_expect(__all((pmax - m_reg) * SCALE <= THR), 1)) { mn = m_reg; alpha = 1.f; }
    else { mn = fmaxf(m_reg, pmax); alpha = __builtin_amdgcn_exp2f((m_reg - mn) * C2); m_reg = mn; }
    const float mnL = -mn * C2;
    for (int r = 0; r < 16; ++r) p0[r] = fmaf(p0[r], C2, mnL); for (int r = 0; r < 16; ++r) p1[r] = fmaf(p1[r], C2, mnL);
    for (int r = 0; r < 16; ++r) p0[r] = __builtin_amdgcn_exp2f(p0[r]);
}
#define FOX_PK4(P, B_, OUT) do { unsigned a0 = cvtpk(P[B_+0], P[B_+1]), a1 = cvtpk(P[B_+2], P[B_+3]);                          \
        unsigned b0 = cvtpk(P[B_+4], P[B_+5]), b1 = cvtpk(P[B_+6], P[B_+7]);                                             \
        auto r0 = __builtin_amdgcn_permlane32_swap(a0, b0, false, false); auto r1 = __builtin_amdgcn_permlane32_swap(a1, b1, false, false); \
        v4u w = {r0[0], r1[0], r0[1], r1[1]}; OUT = *reinterpret_cast<bf16x8*>(&w); } while (0)
__device__ __forceinline__ void finishSM(f32x16& p0, f32x16& p1, float alpha, float& l_reg, bf16x8& pa0, bf16x8& pa1, bf16x8& pa2, bf16x8& pa3) {
    for (int r = 0; r < 16; ++r) p1[r] = __builtin_amdgcn_exp2f(p1[r]);
    float ps = 0; for (int r = 0; r < 16; ++r) ps += p0[r]; for (int r = 0; r < 16; ++r) ps += p1[r];
    { auto rr = __builtin_amdgcn_permlane32_swap(__float_as_uint(ps), __float_as_uint(ps), false, false);
      ps = __uint_as_float(rr[0]) + __uint_as_float(rr[1]); }
    l_reg = l_reg * alpha + ps;
    FOX_PK4(p0, 0, pa0); FOX_PK4(p0, 8, pa1); FOX_PK4(p1, 0, pa2); FOX_PK4(p1, 8, pa3);
}
template <int KB>
__device__ __forceinline__ void qkt(f32x16& p0, f32x16& p1, const char* K_lds, int r32, int hi, const bf16x8* qr) {
    const char* kb[4];
#pragma unroll
    for (int dd = 0; dd < 4; ++dd) kb[dd] = K_lds + KB * SHM_K + KSWZ(r32, (dd * 16 + hi * 8) * 2);
#pragma unroll
    for (int d0 = 0; d0 < 8; ++d0) { const char* a = kb[d0 & 3] + (d0 >> 2) * 128;
        bf16x8 b0 = *reinterpret_cast<const bf16x8*>(a);
        bf16x8 b1 = *reinterpret_cast<const bf16x8*>(a + 32 * 256);
        p0 = __builtin_amdgcn_mfma_f32_32x32x16_bf16(b0, qr[d0], p0, 0, 0, 0);
        p1 = __builtin_amdgcn_mfma_f32_32x32x16_bf16(b1, qr[d0], p1, 0, 0, 0); }
}
#define FOX_TRRD(dst, off) asm volatile("ds_read_b64_tr_b16 %0, %1 offset:%2" : "=&v"(dst) : "v"(vb0), "i"(off) : "memory")
#define FOX_PV_D0(d0, VB) do { s16x4 l0, l1, l2, l3, h0, h1, h2, h3; constexpr int b_ = (VB) * SHM_V + v_rd_off(d0, 0, 0);   \
        FOX_TRRD(l0, b_); FOX_TRRD(h0, b_ + 2048); FOX_TRRD(l1, b_ + 4096); FOX_TRRD(h1, b_ + 6144); FOX_TRRD(l2, b_ + 8192); FOX_TRRD(h2, b_ + 10240); FOX_TRRD(l3, b_ + 12288); FOX_TRRD(h3, b_ + 14336); \
        asm volatile("s_waitcnt lgkmcnt(0)" ::: "memory"); SBAR();   \
        o[d0] = __builtin_amdgcn_mfma_f32_32x32x16_bf16(pa0, (bf16x8){l0[0], l0[1], l0[2], l0[3], h0[0], h0[1], h0[2], h0[3]}, o[d0], 0, 0, 0);   \
        o[d0] = __builtin_amdgcn_mfma_f32_32x32x16_bf16(pa1, (bf16x8){l1[0], l1[1], l1[2], l1[3], h1[0], h1[1], h1[2], h1[3]}, o[d0], 0, 0, 0);   \
        o[d0] = __builtin_amdgcn_mfma_f32_32x32x16_bf16(pa2, (bf16x8){l2[0], l2[1], l2[2], l2[3], h2[0], h2[1], h2[2], h2[3]}, o[d0], 0, 0, 0);   \
        o[d0] = __builtin_amdgcn_mfma_f32_32x32x16_bf16(pa3, (bf16x8){l3[0], l3[1], l3[2], l3[3], h3[0], h3[1], h3[2], h3[3]}, o[d0], 0, 0, 0); } while (0)
template <int VB>
__device__ __forceinline__ void pv_tile(f32x16* o, int vb0, bf16x8 pa0, bf16x8 pa1, bf16x8 pa2, bf16x8 pa3) {
    FOX_PV_D0(0, VB); FOX_PV_D0(1, VB); FOX_PV_D0(2, VB); FOX_PV_D0(3, VB);
}

struct BlockRef { const bf16* Q; const bf16* K; const bf16* V; bf16* O; float* ML; int P0, jlo, jhi; };
struct Seam { bf16x8 qr[8]; bf16x8 st_v0, st_v1, st_k0, st_k1; };
#define ROW(p, k0, rr) (((p) + (size_t)(k0) * RS) + (unsigned)((rr) * RS + sc))
#define VMW() asm volatile("s_waitcnt vmcnt(0)" ::: "memory")
#define VMWN(n) asm volatile("s_waitcnt vmcnt(%0)" :: "i"(n) : "memory")
#define SLOAD_H(Kp, Vp, k0) do { S.st_v0 = load8(ROW(Vp, k0, sr)); S.st_v1 = load8(ROW(Vp, k0, 32 + sr));              \
                         S.st_k0 = load8(ROW(Kp, k0, sr)); S.st_k1 = load8(ROW(Kp, k0, 32 + sr)); } while (0)
#define SWRITE_HK(bf) do { *(bf16x8*)(K_lds + (bf) * SHM_K + kws) = S.st_k0; *(bf16x8*)(K_lds + (bf) * SHM_K + kws + 32 * 256) = S.st_k1; } while (0)
#define SWRITE_HV(bf) do { *(bf16x8*)(V_lds + (bf) * SHM_V + vst0) = S.st_v0; *(bf16x8*)(V_lds + (bf) * SHM_V + vst1) = S.st_v1; } while (0)
#define SWRITE_H(bf) do { SWRITE_HV(bf); SWRITE_HK(bf); } while (0)
#define BIASLD(P0_, P1_, kb_) do { const float* nb_ = nbl + (kb_) + 4 * hi; _Pragma("unroll") for (int j_ = 0; j_ < 4; ++j_) { const f32x4 a_ = *(const f32x4*)(nb_ + 8 * j_), b_ = *(const f32x4*)(nb_ + 32 + 8 * j_); \
        P0_[4 * j_] = a_[0]; P0_[4 * j_ + 1] = a_[1]; P0_[4 * j_ + 2] = a_[2]; P0_[4 * j_ + 3] = a_[3]; P1_[4 * j_] = b_[0]; P1_[4 * j_ + 1] = b_[1]; P1_[4 * j_ + 2] = b_[2]; P1_[4 * j_ + 3] = b_[3]; } } while (0)
constexpr int NPERHEAD = 48, NITEM = 16 * NPERHEAD;
__device__ __forceinline__ int item_code(int k) {
    constexpr unsigned char tab[48] = {124, 125, 62, 120, 121, 116, 117, 58, 112, 113, 108, 109, 54, 104, 105, 100, 101, 50, 96, 97, 92, 93, 46, 88, 89, 84, 85, 42, 80, 81, 76, 77, 38, 72, 73, 68, 69, 34, 64, 65, 30, 26, 22, 18, 14, 10, 6, 2};
    return __builtin_amdgcn_readfirstlane((int)tab[k]);
}
struct ItemQ { unsigned* tick; volatile LAS unsigned* bc; const float* NB; const unsigned* NORM; const bf16* Q; const bf16* K; const bf16* V; bf16* O; bf16* OP; float* ML; int xq; };
__device__ __forceinline__ int item_head(int it) { return 2 * (it / 96) + ((it % 96) >= NPERHEAD ? 1 : 0); }
__device__ __forceinline__ int q_pull(const ItemQ& q, const int tid) {
    if (tid == 0) { unsigned r = (unsigned)NITEM;
        for (int a = 0; a < 8; ++a) { const unsigned qx = (unsigned)(q.xq + a) & 7u; const unsigned k = atomicAdd(q.tick + 64 * qx, 1u); if (k < 96u) { r = qx * 96u + k; break; } }
        q.bc[0] = r; }
    __syncthreads(); const int it = __builtin_amdgcn_readfirstlane((int)q.bc[0]); __syncthreads();
    return it;
}
__device__ __forceinline__ BlockRef q_ref(const ItemQ& q, int it, int lane) {
    const int hd = item_head(it), code = item_code((it % 96) % NPERHEAD), qb = code >> 2, part = code & 3; const float* nbh = q.NB + (size_t)hd * 8192;
    const float braw = sqrtf(__uint_as_float(q.NORM[hd]) * __uint_as_float(q.NORM[16 + hd])), thr = -(104.5f / SCALE + 2.f * braw), ref = nbh[qb * QB];
    const int nt = 4 * (qb + 1);
    const bool s0 = (lane < nt) && (nbh[(unsigned)(64 * lane + 63)] - ref < thr), s1 = (lane + 64 < nt) && (nbh[(unsigned)(64 * (lane + 64) + 63)] - ref < thr);
    int jl = __builtin_amdgcn_readfirstlane(__popcll(__ballot(s0)) + __popcll(__ballot(s1))); if (jl > nt - 4) jl = nt - 4;
    BlockRef r; r.Q = q.Q + (size_t)qb * QB * RS + hd * D; r.K = q.K + hd * D; r.V = q.V + hd * D; r.P0 = qb * QB;
    const size_t oo = (size_t)qb * QB * RS + hd * D;
    if (part == 2) { r.O = q.O + oo; r.ML = nullptr; r.jlo = jl; r.jhi = nt; }
    else { const int d0 = 4 * qb; int j0 = jl < d0 - 1 ? jl : d0 - 1; int jm = j0 + (nt - j0) / 2; if (jm > d0) jm = d0; if (jm < j0 + 1) jm = j0 + 1;
        r.O = q.OP + (size_t)part * 8192 * RS + oo; r.ML = q.ML + (size_t)part * 8192 * 32 + hd * 2;
        if (part == 0) { r.jlo = j0; r.jhi = jm; } else { r.jlo = jm; r.jhi = nt; } }
    return r;
}
__device__ __forceinline__ void causal_prime(const BlockRef& cur, char* lds, Seam& S, const int tid) {
    const int wid = __builtin_amdgcn_readfirstlane(tid >> 6), lane = tid & 63, r32 = lane & 31, hi = lane >> 5;
    const int sr = tid >> 4, sc = (tid & 15) * 8, kws = KSWZ(sr, sc * 2); char* K_lds = lds + 2 * SHM_V;
    const int kb0 = cur.jlo * KVBLK;
    for (int d0 = 0; d0 < 8; ++d0) S.qr[d0] = load8(cur.Q + (unsigned)((wid * QBLK + r32) * RS + d0 * 16 + hi * 8));
    SLOAD_H(cur.K, cur.V, kb0); VMW(); SWRITE_HK(0);
    __syncthreads();
}
__device__ __forceinline__ void causal_block(const BlockRef& cur, BlockRef& nxt, int& itn, const ItemQ& iq, int skv, char* lds, Seam& S, const int tid) {
    const int W = 1 << 30;
    const int wid = __builtin_amdgcn_readfirstlane(tid >> 6), lane = tid & 63, r32 = lane & 31, hi = lane >> 5;
    const int j_lo = cur.jlo;
    const int j_hi = cur.jhi;
    const int NT = j_hi - j_lo;
    const int qlo = cur.P0 + wid * QBLK, qm = qlo + r32 - 4 * hi;
    char* V_lds = lds; char* K_lds = lds + 2 * SHM_V;
    float* ws = (float*)(lds + 2 * SHM_V + 2 * SHM_K) + wid * 64; float* li_l = ws, * al_l = ws + 32; const float* nbl = (const float*)(lds + LDS_BYTES);
    float m_reg = -1e30f, l_reg = 0; f32x16 o[4] = {};
    const int sr = tid >> 4, sc = (tid & 15) * 8, vst0 = v_st(sr, sc), vst1 = v_st(32 + sr, sc), kws = KSWZ(sr, sc * 2);
    const int vb0 = (int)(uintptr_t)V_lds + v_rd_base(lane);
    const bf16* Kh = cur.K; const bf16* Vh = cur.V;
#define RESC(a) do { if (__any((a) < 1.f)) { if (hi == 0) al_l[r32] = (a); asm volatile("s_waitcnt lgkmcnt(0)" ::: "memory");              \
                     for (int d_ = 0; d_ < 4; ++d_) for (int r = 0; r < 16; ++r) o[d_][r] *= al_l[crow(r, hi)]; } } while (0)
#define KBASE(t) ((j_lo + (t)) * KVBLK)
#define MASKT(P0_, P1_, t) do { const int kb_ = KBASE(t); if (kb_ + KVBLK - 1 > qlo) mask_tile(P0_, P1_, qm - kb_, (unsigned)W); } while (0)
    constexpr int NQL = 8;
#define SEAM_K0() do { VMWN(NQL); SWRITE_HK(0); SBAR(); } while (0)
    f32x16 pA0, pA1, pB0, pB1; float alA, alB; bf16x8 pa0, pa1, pa2, pa3;
    SWRITE_HV(0); SBAR();
    if (NT > 1) { SLOAD_H(Kh, Vh, KBASE(1)); }
    SBAR(); BIASLD(pA0, pA1, KBASE(0)); qkt<0>(pA0, pA1, K_lds, r32, hi, S.qr);
    MASKT(pA0, pA1, 0); partialSM(pA0, pA1, m_reg, alA);
    if (NT > 1) { VMW(); SWRITE_H(1); BIASLD(pB0, pB1, KBASE(1)); }
    __syncthreads();
#define HALF_STEP(PX0, PX1, alX, PY0, PY1, alY, t, KB, VB, SB) do {                                                      \
        SBAR(); qkt<KB>(PX0, PX1, K_lds, r32, hi, S.qr);                                             \
        finishSM(PY0, PY1, alY, l_reg, pa0, pa1, pa2, pa3); SBAR();                                                           \
        if ((t) + 1 < NT) { SLOAD_H(Kh, Vh, KBASE((t) + 1)); SBAR(); }                                               \
        pv_tile<VB>(o, vb0, pa0, pa1, pa2, pa3); MASKT(PX0, PX1, (t)); partialSM(PX0, PX1, m_reg, alX);                                        \
        __syncthreads();                                                                                                      \
        if ((t) + 1 < NT) { VMW(); SWRITE_H(SB); }                                                                          \
        RESC(alX); if ((t) + 1 < NT) { BIASLD(PY0, PY1, KBASE((t) + 1)); } __syncthreads(); } while (0)
    for (int t = 1; t + 1 < NT; t += 2) {
        HALF_STEP(pB0, pB1, alB, pA0, pA1, alA, t, 1, 0, 0);
        HALF_STEP(pA0, pA1, alA, pB0, pB1, alB, t + 1, 0, 1, 1);
    }
    const bool even = (NT & 1) == 0;
    if (even) { SBAR(); qkt<1>(pB0, pB1, K_lds, r32, hi, S.qr); SBAR(); }
    { int lt_ = tid; asm volatile("" : "+v"(lt_)); itn = q_pull(iq, lt_); if (itn < NITEM) nxt = q_ref(iq, itn, lt_ & 63); else nxt = cur; }
    const int kbn = nxt.jlo * KVBLK;
    SLOAD_H(nxt.K, nxt.V, kbn); SBAR();
    { int lq_ = lane; asm volatile("" : "+v"(lq_)); const unsigned qo_ = (unsigned)((wid * QBLK + (lq_ & 31)) * RS + (lq_ >> 5) * 8);
#pragma unroll
      for (int d0 = 0; d0 < 8; ++d0) S.qr[d0] = load8(nxt.Q + (qo_ + (unsigned)(d0 * 16))); }
    SBAR();
    finishSM(pA0, pA1, alA, l_reg, pa0, pa1, pa2, pa3); SBAR();
    pv_tile<0>(o, vb0, pa0, pa1, pa2, pa3);
    if (even) { MASKT(pB0, pB1, NT - 1); partialSM(pB0, pB1, m_reg, alB); __syncthreads(); RESC(alB);
        finishSM(pB0, pB1, alB, l_reg, pa0, pa1, pa2, pa3); SBAR(); pv_tile<1>(o, vb0, pa0, pa1, pa2, pa3); }
    SBAR(); SEAM_K0();
    if (hi == 0) li_l[r32] = l_reg; asm volatile("s_waitcnt lgkmcnt(0)" ::: "memory");
    float rli[16];
#pragma unroll
    for (int r = 0; r < 16; ++r) rli[r] = __builtin_amdgcn_rcpf(li_l[crow(r, hi)]);
    bf16* Ow = cur.O;
    { int le_ = lane; asm volatile("" : "+v"(le_)); const int r32e = le_ & 31, hie = le_ >> 5;
      const unsigned ob_ = (unsigned)((wid * QBLK + 4 * hie) * RS + r32e);
#pragma unroll
      for (int r = 0; r < 16; ++r) { const int orow = crow(r, 0);
#pragma unroll
        for (int d0 = 0; d0 < 4; ++d0) { const float v = o[d0][r] * rli[r];
            const float vn = __shfl_xor(v, 1);
            if ((r32e & 1) == 0) *(unsigned*)(Ow + (ob_ + (unsigned)(orow * RS + d0 * 32))) = cvtpk(v, vn); } }
      if (cur.ML != nullptr && hie == 0) { f32x2_t ml = {m_reg, l_reg}; *(f32x2_t*)(cur.ML + (unsigned)((cur.P0 + wid * QBLK + r32e) * 32)) = ml; } }
    __syncthreads();
#undef RESC
#undef KBASE
#undef MASKT
#undef SEAM_K0
#undef HALF_STEP
}
#undef ROW
#undef VMW
#undef VMWN
#undef SLOAD_H
#undef SWRITE_HK
#undef SWRITE_HV
#undef SWRITE_H
#undef BIASLD
}
constexpr int NWAVES_ = 8;
struct Frame {
    LAS unsigned char* lds;
    int tid, lane, wave, bx;
    int vcu, G;
    int gw, NGW;
    int gt, NGT;
};

struct P0Item { const float* W; unsigned char* WT; int K, N, ldw, item, fp8; };
__device__ __forceinline__ void p0_load(const P0Item& I, int lane, float (&tmp)[32]) {
    const int nblk = I.N / 32, kb = I.item / nblk, nb = I.item % nblk, k0 = 64 * kb, n0 = 32 * nb;
#pragma unroll
    for (int i = 0; i < 32; ++i) tmp[i] = __builtin_nontemporal_load(I.W + (size_t)(k0 + 2 * i + (lane >> 5)) * I.ldw + n0 + (lane & 31));
}
__device__ __forceinline__ v2u pack8_fp8(f32x4 a, f32x4 b) {
    int p = __builtin_amdgcn_cvt_pk_fp8_f32(a[0], a[1], 0, false); p = __builtin_amdgcn_cvt_pk_fp8_f32(a[2], a[3], p, true);
    int q = __builtin_amdgcn_cvt_pk_fp8_f32(b[0], b[1], 0, false); q = __builtin_amdgcn_cvt_pk_fp8_f32(b[2], b[3], q, true);
    return (v2u){(unsigned)p, (unsigned)q};
}
__device__ __forceinline__ void p0_emit(const P0Item& I, int lane, const float (&tmp)[32], LAS float* scr) {
    const int nblk = I.N / 32, kb = I.item / nblk, nb = I.item % nblk, k0 = 64 * kb, n0 = 32 * nb, K = I.K;
#pragma unroll
    for (int i = 0; i < 32; ++i) scr[(2 * i + (lane >> 5)) * 33 + (lane & 31)] = tmp[i];
    LDS_WAIT(); asm volatile("" ::: "memory");
    const int c = lane & 7;
    if (I.fp8) {
#pragma unroll
        for (int j = 0; j < 4; ++j) { const int n = (lane >> 3) + 8 * j; const LAS float* s = scr + (8 * c) * 33 + n;
            const f32x4 a = {s[0 * 33] * 64.f, s[1 * 33] * 64.f, s[2 * 33] * 64.f, s[3 * 33] * 64.f}, b = {s[4 * 33] * 64.f, s[5 * 33] * 64.f, s[6 * 33] * 64.f, s[7 * 33] * 64.f};
            *(GAS v2u*)(I.WT + (size_t)(n0 + n) * K + k0 + 8 * c) = pack8_fp8(a, b); }
    } else {
#pragma unroll
        for (int j = 0; j < 4; ++j) { const int n = (lane >> 3) + 8 * j; const LAS float* s = scr + (8 * c) * 33 + n;
            v4u o; o.x = cvtpk(s[0 * 33], s[1 * 33]); o.y = cvtpk(s[2 * 33], s[3 * 33]); o.z = cvtpk(s[4 * 33], s[5 * 33]); o.w = cvtpk(s[6 * 33], s[7 * 33]);
            *(GAS v4u*)((bf16*)I.WT + (size_t)(n0 + n) * K + k0 + 8 * c) = o; }
    }
    LDS_WAIT(); asm volatile("" ::: "memory");
}
__device__ __forceinline__ void cvt_f32_bf16(const Frame& F, const float* src, bf16* dst, size_t n8) {
    for (size_t i0 = F.gt; i0 < n8; i0 += (size_t)4 * F.NGT) {
        f32x4 a[4], b[4];
#pragma unroll
        for (int u = 0; u < 4; ++u) { const size_t i = i0 + (size_t)u * F.NGT; if (i < n8) { a[u] = __builtin_nontemporal_load((const f32x4*)(src + i * 8)); b[u] = __builtin_nontemporal_load((const f32x4*)(src + i * 8 + 4)); } }
#pragma unroll
        for (int u = 0; u < 4; ++u) { const size_t i = i0 + (size_t)u * F.NGT; if (i < n8) { v4u o; o.x = cvtpk(a[u][0], a[u][1]); o.y = cvtpk(a[u][2], a[u][3]); o.z = cvtpk(b[u][0], b[u][1]); o.w = cvtpk(b[u][2], b[u][3]); *(v4u*)(dst + i * 8) = o; } }
    }
}
__device__ __forceinline__ void row_load(const float* xrow, int lane, f32x4 (&v)[8]) {
#pragma unroll
    for (int j = 0; j < 4; ++j) { v[2 * j] = *(const f32x4*)(xrow + lane * 8 + 512 * j); v[2 * j + 1] = *(const f32x4*)(xrow + lane * 8 + 512 * j + 4); }
}
__device__ __forceinline__ void row_load_nt(const float* xrow, int lane, f32x4 (&v)[8]) {
#pragma unroll
    for (int j = 0; j < 4; ++j) { v[2 * j] = __builtin_nontemporal_load((const f32x4*)(xrow + lane * 8 + 512 * j)); v[2 * j + 1] = __builtin_nontemporal_load((const f32x4*)(xrow + lane * 8 + 512 * j + 4)); }
}
__device__ __forceinline__ float row_rstd(const f32x4 (&v)[8]) {
    float s = 0.f;
#pragma unroll
    for (int j = 0; j < 8; ++j) s += (v[j][0] * v[j][0] + v[j][1] * v[j][1]) + (v[j][2] * v[j][2] + v[j][3] * v[j][3]);
    return 1.f / sqrtf(wave_sum(s) * (1.f / DM) + RMS_EPS);
}
__device__ __forceinline__ void row_store_norm(const f32x4 (&v)[8], float rstd, const float* w, bf16* orow, int lane) {
#pragma unroll
    for (int j = 0; j < 4; ++j) { const f32x4 w0 = *(const f32x4*)(w + lane * 8 + 512 * j), w1 = *(const f32x4*)(w + lane * 8 + 512 * j + 4);
        const f32x4 a = v[2 * j] * rstd * w0, b = v[2 * j + 1] * rstd * w1;
        v4u o; o.x = cvtpk(a[0], a[1]); o.y = cvtpk(a[2], a[3]); o.z = cvtpk(b[0], b[1]); o.w = cvtpk(b[2], b[3]);
        *(v4u*)(orow + lane * 8 + 512 * j) = o; }
}
__device__ __forceinline__ void row_store_norm8(const f32x4 (&v)[8], float rstd, const float* w, unsigned char* orow, int lane) {
#pragma unroll
    for (int j = 0; j < 4; ++j) { const f32x4 w0 = *(const f32x4*)(w + lane * 8 + 512 * j), w1 = *(const f32x4*)(w + lane * 8 + 512 * j + 4);
        *(v2u*)(orow + lane * 8 + 512 * j) = pack8_fp8(v[2 * j] * rstd * w0, v[2 * j + 1] * rstd * w1); }
}
template <bool NT = false>
__device__ __forceinline__ void norm_phase(const Frame& F, const float* X, const float* w, bf16* XN, unsigned char* XN8 = nullptr) {
    int m = F.gw; if (m >= SEQ) return;
    f32x4 va[8], vb[8];
    if (NT) row_load_nt(X + (size_t)m * DM, F.lane, va); else row_load(X + (size_t)m * DM, F.lane, va);
    for (;;) {
        const int m1 = m + F.NGW; const bool h1 = m1 < SEQ;
        if (h1) { if (NT) row_load_nt(X + (size_t)m1 * DM, F.lane, vb); else row_load(X + (size_t)m1 * DM, F.lane, vb); }
        { const float rstd = row_rstd(va); row_store_norm(va, rstd, w, XN + (size_t)m * DM, F.lane); if (XN8) row_store_norm8(va, rstd, w, XN8 + (size_t)m * DM, F.lane); }
        if (!h1) break;
        const int m2 = m1 + F.NGW; const bool h2 = m2 < SEQ;
        if (h2) { if (NT) row_load_nt(X + (size_t)m2 * DM, F.lane, va); else row_load(X + (size_t)m2 * DM, F.lane, va); }
        { const float rstd = row_rstd(vb); row_store_norm(vb, rstd, w, XN + (size_t)m1 * DM, F.lane); if (XN8) row_store_norm8(vb, rstd, w, XN8 + (size_t)m1 * DM, F.lane); }
        if (!h2) break;
        m = m2;
    }
}
__device__ __forceinline__ void final_norm_phase(const Frame& F, const float* X, const float* w, float* out) {
    for (int m = F.gw; m < SEQ; m += F.NGW) { f32x4 v[8]; row_load(X + (size_t)m * DM, F.lane, v); const float rstd = row_rstd(v);
#pragma unroll
        for (int j = 0; j < 4; ++j) { const f32x4 w0 = *(const f32x4*)(w + F.lane * 8 + 512 * j), w1 = *(const f32x4*)(w + F.lane * 8 + 512 * j + 4);
            *(f32x4*)(out + (size_t)m * DM + F.lane * 8 + 512 * j) = v[2 * j] * rstd * w0; *(f32x4*)(out + (size_t)m * DM + F.lane * 8 + 512 * j + 4) = v[2 * j + 1] * rstd * w1; } }
}
__device__ __forceinline__ void kvnorm_stage(const Frame& F, const float* wkvf) {
    LAS f32x4* wl = (LAS f32x4*)F.lds;
    for (int u = F.tid; u < 8192; u += NWAVES_ * 64) { const int ln = u & 63, q = (u >> 6) & 3, je = u >> 8, k = ln * 8 + 512 * (je >> 3) + (je & 7);
        wl[u] = *(const f32x4*)(wkvf + (size_t)k * 4112 + 4096 + 4 * q); }
    __syncthreads();
}
__device__ __forceinline__ void kvnorm_rows(const Frame& F, const float* X, const float* kvw, const float* bw, const float* b_f, unsigned char* XN, unsigned char* XN2, float* LOGF) {
    LAS f32x4* wl = (LAS f32x4*)F.lds;
    for (int m = F.gw; m < SEQ; m += F.NGW) {
        f32x4 v[8]; row_load(X + (size_t)m * DM, F.lane, v); const float rstd = row_rstd(v);
        row_store_norm8(v, rstd, bw, XN2 + (size_t)m * DM, F.lane);
        row_store_norm8(v, rstd, kvw, XN + (size_t)m * DM, F.lane);
        f32x4 acc[4];
#pragma unroll
        for (int q = 0; q < 4; ++q) acc[q] = (f32x4){0.f, 0.f, 0.f, 0.f};
#pragma unroll
        for (int j = 0; j < 4; ++j) { const f32x4 k0 = *(const f32x4*)(kvw + F.lane * 8 + 512 * j), k1 = *(const f32x4*)(kvw + F.lane * 8 + 512 * j + 4);
#pragma unroll
            for (int e = 0; e < 8; ++e) { const float xv = v[2 * j + (e >> 2)][e & 3] * rstd * (e < 4 ? k0[e & 3] : k1[e & 3]);
                if ((e & 1) == 0) asm volatile("" ::: "memory");
#pragma unroll
                for (int q = 0; q < 4; ++q) acc[q] += wl[((j * 8 + e) * 4 + q) * 64 + F.lane] * xv; } }
        float mine = 0.f;
#pragma unroll
        for (int f = 0; f < 16; ++f) { const float s = wave_sum(acc[f >> 2][f & 3]); if (F.lane == f) mine = s; }
        if (F.lane < 16) { const float z = mine + b_f[F.lane]; LOGF[(size_t)m * 16 + F.lane] = fminf(z, 0.f) - log1pf(__expf(-fabsf(z))); }
    }
}
__device__ __forceinline__ void cumsum_unit(const Frame& F, int f, const float* LOGF, float* NB) {
    LAS float* wt = (LAS float*)F.lds;
    float loc[16]; float s = 0.f;
#pragma unroll
    for (int i = 0; i < 16; ++i) { s += LOGF[(size_t)(F.tid * 16 + i) * 16 + f]; loc[i] = s; }
    float incl = s;
#pragma unroll
    for (int o = 1; o < 64; o <<= 1) { const float n = __shfl_up(incl, o); if (F.lane >= o) incl += n; }
    if (F.lane == 63) wt[F.wave] = incl;
    __syncthreads();
    float pre = incl - s;
    for (int w = 0; w < F.wave; ++w) pre += wt[w];
    const float inv = -1.f / fox::SCALE;
#pragma unroll
    for (int i = 0; i < 16; ++i) NB[(size_t)f * SEQ + F.tid * 16 + i] = (pre + loc[i]) * inv;
    __syncthreads();
}
__device__ __forceinline__ void conv_phase(const Frame& F, const bf16* XBC, const float* cw, const float* cb, bf16* XBCC) {
    constexpr int NCG = CONVD / 8, SEGT = 16, NSEG = SEQ / SEGT;
    for (int id = F.gt; id < NCG * NSEG; id += F.NGT) {
        const int cg_ = id % NCG, seg = id / NCG, c0 = cg_ * 8, t0 = seg * SEGT;
        float w[4][8], b[8];
#pragma unroll
        for (int k = 0; k < 4; ++k) { const f32x4 a = *(const f32x4*)(cw + k * CONVD + c0), bq = *(const f32x4*)(cw + k * CONVD + c0 + 4);
#pragma unroll
            for (int e = 0; e < 4; ++e) { w[k][e] = a[e]; w[k][4 + e] = bq[e]; } }
        { const f32x4 a = *(const f32x4*)(cb + c0), bq = *(const f32x4*)(cb + c0 + 4);
#pragma unroll
          for (int e = 0; e < 4; ++e) { b[e] = a[e]; b[4 + e] = bq[e]; } }
        v4u raw[SEGT + 3];
#pragma unroll
        for (int i = 0; i < SEGT + 3; ++i) { const int t = t0 - 3 + i; raw[i] = (t >= 0) ? *(const v4u*)(XBC + (size_t)t * CONVD + c0) : (v4u){0u, 0u, 0u, 0u}; }
#pragma unroll
        for (int i = 0; i < SEGT; ++i) { float y[8];
#pragma unroll
            for (int e = 0; e < 8; ++e) { float s = b[e];
#pragma unroll
                for (int k = 0; k < 4; ++k) { const unsigned u = raw[i + k][e >> 1]; s += w[k][e] * ((e & 1) ? bfhi(u) : bflo(u)); }
                y[e] = siluf_(s); }
            v4u o; o.x = cvtpk(y[0], y[1]); o.y = cvtpk(y[2], y[3]); o.z = cvtpk(y[4], y[5]); o.w = cvtpk(y[6], y[7]);
            *(v4u*)(XBCC + (size_t)(t0 + i) * CONVD + c0) = o; }
    }
}
__device__ __forceinline__ void acum_unit(const Frame& F, int c, float* DT, const float* dtb, const float* A_log, float* ACL) {
    LAS float* tot = (LAS float*)F.lds;
    const int h = F.tid & 63, seg = F.tid >> 6; const float a = -__expf(A_log[h]) * LOG2E;
    float loc[32]; float s = 0.f; const int tb = c * CHK + seg * 32; const float bias = dtb[h];
#pragma unroll
    for (int i = 0; i < 32; ++i) { const float xr = DT[(size_t)(tb + i) * 64 + h] + bias; const float d = fmaxf(xr, 0.f) + log1pf(__expf(-fabsf(xr))); DT[(size_t)(tb + i) * 64 + h] = d; s += d * a; loc[i] = s; }
    tot[seg * 64 + h] = s;
    __syncthreads();
    float pre = 0.f;
    for (int q = 0; q < seg; ++q) pre += tot[q * 64 + h];
#pragma unroll
    for (int i = 0; i < 32; ++i) ACL[(size_t)(tb + i) * 64 + h] = pre + loc[i];
    __syncthreads();
}
__device__ __forceinline__ void gnorm_load(const bf16* Y, const bf16* Z, int it0, int lane, v4u (&yr)[4], v4u (&zr)[4]) {
#pragma unroll
    for (int u = 0; u < 4; ++u) { const int it = it0 + u; const size_t off = (size_t)(it >> 3) * DI + (it & 7) * 512 + lane * 8; yr[u] = *(const v4u*)(Y + off); zr[u] = *(const v4u*)(Z + off); }
}
__device__ __forceinline__ void gnorm_emit(bf16* Y, const float* gw_, int it0, int lane, const v4u (&yr)[4], const v4u (&zr)[4], const bool dry) {
#pragma unroll
    for (int u = 0; u < 4; ++u) { const int it = it0 + u, g = it & 7; const size_t off = (size_t)(it >> 3) * DI + g * 512 + lane * 8;
        float y[8] = {bflo(yr[u].x), bfhi(yr[u].x), bflo(yr[u].y), bfhi(yr[u].y), bflo(yr[u].z), bfhi(yr[u].z), bflo(yr[u].w), bfhi(yr[u].w)};
        const float z[8] = {bflo(zr[u].x), bfhi(zr[u].x), bflo(zr[u].y), bfhi(zr[u].y), bflo(zr[u].z), bfhi(zr[u].z), bflo(zr[u].w), bfhi(zr[u].w)};
        float s = 0.f;
#pragma unroll
        for (int e = 0; e < 8; ++e) { y[e] = y[e] * siluf_(z[e]); s += y[e] * y[e]; }
        const float r = 1.f / sqrtf(wave_sum(s) * (1.f / 512.f) + GN_EPS);
        const f32x4 w0 = *(const f32x4*)(gw_ + g * 512 + lane * 8), w1 = *(const f32x4*)(gw_ + g * 512 + lane * 8 + 4);
        v4u o; o.x = cvtpk(y[0] * r * w0[0], y[1] * r * w0[1]); o.y = cvtpk(y[2] * r * w0[2], y[3] * r * w0[3]); o.z = cvtpk(y[4] * r * w1[0], y[5] * r * w1[1]); o.w = cvtpk(y[6] * r * w1[2], y[7] * r * w1[3]);
        if (!dry) *(v4u*)(Y + off) = o; }
}
__device__ __forceinline__ void gnorm_phase(const Frame& F, bf16* Y, const bf16* Z, const float* gw_, const bool dry) {
    const int N = SEQ * NG, st = F.NGW * 4;
    int it0 = F.gw * 4; if (it0 >= N) return;
    v4u ya[4], za[4], yb[4], zb[4];
    gnorm_load(Y, Z, it0, F.lane, ya, za);
    for (;;) {
        const int it1 = it0 + st; const bool h1 = it1 < N;
        if (h1) gnorm_load(Y, Z, it1, F.lane, yb, zb);
        gnorm_emit(Y, gw_, it0, F.lane, ya, za, dry);
        if (!h1) break;
        const int it2 = it1 + st; const bool h2 = it2 < N;
        if (h2) gnorm_load(Y, Z, it2, F.lane, ya, za);
        gnorm_emit(Y, gw_, it1, F.lane, yb, zb, dry);
        if (!h2) break;
        it0 = it2;
    }
}
__device__ __forceinline__ void dt_unit(LAS unsigned char* ldsu, int tt, const bf16* XN, const bf16* Wdt, float* DT, const int tid) {
    const int wid = __builtin_amdgcn_readfirstlane(tid >> 6), lane = tid & 63, r32 = lane & 31, hi = lane >> 5, t0 = tt * 32;
    f32x16 acc0 = f32x16{}, acc1 = f32x16{};
    const bf16* ap = XN + (size_t)(t0 + r32) * DM + 256 * wid + 8 * hi;
    const bf16* bp = Wdt + (size_t)r32 * DM + 256 * wid + 8 * hi;
#pragma unroll 4
    for (int ks = 0; ks < 16; ++ks) { const bf16x8 a = *(const bf16x8*)(ap + 16 * ks), b0 = *(const bf16x8*)(bp + 16 * ks), b1 = *(const bf16x8*)(bp + 32 * DM + 16 * ks);
        acc0 = __builtin_amdgcn_mfma_f32_32x32x16_bf16(a, b0, acc0, 0, 0, 0); acc1 = __builtin_amdgcn_mfma_f32_32x32x16_bf16(a, b1, acc1, 0, 0, 0); }
    LAS float* red = (LAS float*)ldsu;
#pragma unroll
    for (int r = 0; r < 16; ++r) { const int row = wid * 32 + fox::crow(r, hi); red[row * 64 + r32] = acc0[r]; red[row * 64 + 32 + r32] = acc1[r]; }
    __syncthreads();
    { const int token = tid >> 4, c4 = (tid & 15) * 4; f32x4 s = {0.f, 0.f, 0.f, 0.f};
#pragma unroll
      for (int w = 0; w < 8; ++w) s += *(const LAS f32x4*)(red + (w * 32 + token) * 64 + c4);
      *(f32x4*)(DT + (size_t)(t0 + token) * 64 + c4) = s; }
    __syncthreads();
}

__device__ __forceinline__ void qknorm_phase(const Frame& F, const bf16* Q, const bf16* K, unsigned* NORM) {
    float mq[4] = {0.f, 0.f, 0.f, 0.f}, mk[4] = {0.f, 0.f, 0.f, 0.f};
    for (int m = F.gw; m < 2 * SEQ; m += F.NGW) { const bool isk = m >= SEQ; const bf16* row = isk ? K + (size_t)(m - SEQ) * DM : Q + (size_t)m * DM;
#pragma unroll
        for (int j = 0; j < 4; ++j) { const v4u a = *(const v4u*)(row + F.lane * 8 + 512 * j);
            float s = bflo(a.x) * bflo(a.x) + bfhi(a.x) * bfhi(a.x) + bflo(a.y) * bflo(a.y) + bfhi(a.y) * bfhi(a.y) + bflo(a.z) * bflo(a.z) + bfhi(a.z) * bfhi(a.z) + bflo(a.w) * bflo(a.w) + bfhi(a.w) * bfhi(a.w);
            s += DPP_F(s, 0xB1); s += DPP_F(s, 0x4E); s += DPP_F(s, 0x141); s += DPP_F(s, 0x140);
            if (isk) mk[j] = fmaxf(mk[j], s); else mq[j] = fmaxf(mq[j], s); } }
    LAS float* red = (LAS float*)F.lds;
    if ((F.lane & 15) == 0) {
#pragma unroll
        for (int j = 0; j < 4; ++j) { red[F.wave * 32 + 4 * j + (F.lane >> 4)] = mq[j]; red[F.wave * 32 + 16 + 4 * j + (F.lane >> 4)] = mk[j]; } }
    __syncthreads();
    if (F.tid < 32) { float v = 0.f;
#pragma unroll
        for (int w = 0; w < 8; ++w) v = fmaxf(v, red[w * 32 + F.tid]);
        atomicMax(NORM + F.tid, __float_as_uint(v)); }
    __syncthreads();
}

__device__ __forceinline__ void attn_combine_phase(const Frame& F, bf16* O, const bf16* OP, const float* ML) {
    constexpr float C2 = 1.4426950408889634f * fox::SCALE; constexpr int N = (SEQ / 2) * 4;
    for (int it0 = F.gw; it0 < N; it0 += 4 * F.NGW) {
        f32x2_t a[4], b[4]; v4u p[4], q[4];
#pragma unroll
        for (int u = 0; u < 4; ++u) { const int it = it0 + u * F.NGW; if (it < N) { const int t = SEQ / 2 + (it >> 2), j = it & 3, hd = 4 * j + (F.lane >> 4); const size_t off = (size_t)t * DM + F.lane * 8 + 512 * j;
            a[u] = *(const f32x2_t*)(ML + (size_t)t * 32 + hd * 2); b[u] = *(const f32x2_t*)(ML + (size_t)SEQ * 32 + (size_t)t * 32 + hd * 2);
            p[u] = __builtin_nontemporal_load((const v4u*)(OP + off)); q[u] = __builtin_nontemporal_load((const v4u*)(OP + (size_t)SEQ * DM + off)); } }
#pragma unroll
        for (int u = 0; u < 4; ++u) { const int it = it0 + u * F.NGW; if (it < N) { const int t = SEQ / 2 + (it >> 2), j = it & 3; const size_t off = (size_t)t * DM + F.lane * 8 + 512 * j;
            const float mm = fmaxf(a[u].x, b[u].x); float w0 = a[u].y * __builtin_amdgcn_exp2f((a[u].x - mm) * C2), w1 = b[u].y * __builtin_amdgcn_exp2f((b[u].x - mm) * C2);
            const float inv = 1.f / (w0 + w1); w0 *= inv; w1 *= inv; v4u o;
            o.x = cvtpk(w0 * bflo(p[u].x) + w1 * bflo(q[u].x), w0 * bfhi(p[u].x) + w1 * bfhi(q[u].x)); o.y = cvtpk(w0 * bflo(p[u].y) + w1 * bflo(q[u].y), w0 * bfhi(p[u].y) + w1 * bfhi(q[u].y));
            o.z = cvtpk(w0 * bflo(p[u].z) + w1 * bflo(q[u].z), w0 * bfhi(p[u].z) + w1 * bfhi(q[u].z)); o.w = cvtpk(w0 * bflo(p[u].w) + w1 * bflo(q[u].w), w0 * bfhi(p[u].w) + w1 * bfhi(q[u].w));
            *(v4u*)(O + off) = o; } }
    }
}
namespace ssd {
typedef short v4i16_t __attribute__((ext_vector_type(4)));
using fox::crow;
__device__ __forceinline__ s16x4 vtr(const LAS char* p) { return __builtin_bit_cast(s16x4, __builtin_amdgcn_ds_read_tr16_b64_v4i16((LAS v4i16_t*)p)); }
__device__ __forceinline__ bf16x8 vfrag(const LAS char* tile, int vrb, int d0, int ks) {
    const s16x4 l = vtr(tile + vrb + d0 * 512 + ks * 4096), h = vtr(tile + vrb + d0 * 512 + ks * 4096 + 2048);
    return (bf16x8){l[0], l[1], l[2], l[3], h[0], h[1], h[2], h[3]};
}
__device__ __forceinline__ void s1_unit(LAS unsigned char* ldsu, int c, int g, const bf16* XBCC, const float* DT, const float* ACL, float* SLOC, const int tid) {
    LAS char* lds = (LAS char*)ldsu;
    const int wid = __builtin_amdgcn_readfirstlane(tid >> 6), lane = tid & 63, r32 = lane & 31, hi = lane >> 5;
    const int sr = tid >> 4, sc = (tid & 15) * 8;
    LAS char* Bv = lds; LAS char* Xv = lds + 16384;
    const int vrb = fox::v_rd_base(lane), hd = g * 8 + wid, tlast = c * CHK + CHK - 1;
    f32x16 acc[2][4];
#pragma unroll
    for (int i = 0; i < 2; ++i)
#pragma unroll
        for (int d = 0; d < 4; ++d) acc[i][d] = f32x16{};
#pragma unroll 1
    for (int lt = 0; lt < 4; ++lt) {
        const int t0 = c * CHK + lt * 64;
#pragma unroll 1
        for (int hh = 0; hh < 2; ++hh) { const int row = sr + 32 * hh; const size_t rb = (size_t)(t0 + row) * CONVD;
            *(LAS v4u*)(Bv + fox::v_st(row, sc)) = *(const v4u*)(XBCC + rb + 4096 + g * 128 + sc);
#pragma unroll 2
            for (int vt = 0; vt < 4; ++vt) { const int col = vt * 128 + sc, h2 = g * 8 + (col >> 6);
                const float w = __builtin_amdgcn_exp2f(ACL[(size_t)tlast * 64 + h2] - ACL[(size_t)(t0 + row) * 64 + h2]) * DT[(size_t)(t0 + row) * 64 + h2];
                const v4u xr = *(const v4u*)(XBCC + rb + g * 512 + col);
                v4u o; o.x = cvtpk(bflo(xr.x) * w, bfhi(xr.x) * w); o.y = cvtpk(bflo(xr.y) * w, bfhi(xr.y) * w); o.z = cvtpk(bflo(xr.z) * w, bfhi(xr.z) * w); o.w = cvtpk(bflo(xr.w) * w, bfhi(xr.w) * w);
                *(LAS v4u*)(Xv + vt * 16384 + fox::v_st(row, sc)) = o; } }
        __syncthreads();
        const LAS char* xt = Xv + (wid >> 1) * 16384;
#pragma unroll 1
        for (int ks = 0; ks < 4; ++ks) { const bf16x8 xf0 = vfrag(xt, vrb, 2 * (wid & 1), ks), xf1 = vfrag(xt, vrb, 2 * (wid & 1) + 1, ks);
#pragma unroll
            for (int d = 0; d < 4; ++d) { const bf16x8 bfr = vfrag(Bv, vrb, d, ks);
                acc[0][d] = __builtin_amdgcn_mfma_f32_32x32x16_bf16(xf0, bfr, acc[0][d], 0, 0, 0);
                acc[1][d] = __builtin_amdgcn_mfma_f32_32x32x16_bf16(xf1, bfr, acc[1][d], 0, 0, 0); } }
        __syncthreads();
    }
    int lane2 = lane; asm volatile("" : "+v"(lane2));
    float* out = SLOC + ((size_t)c * NHS + hd) * (HP * NST) + (lane2 >> 5) * 4 * NST + (lane2 & 31);
#pragma unroll
    for (int i = 0; i < 2; ++i)
#pragma unroll
        for (int d = 0; d < 4; ++d)
#pragma unroll
            for (int r = 0; r < 16; ++r) out[(32 * i + crow(r, 0)) * NST + 32 * d] = acc[i][d][r];
}
__device__ __forceinline__ void s2_phase(const Frame& F, const float* SLOC, const float* ACL, bf16* SIN) {
    constexpr int PER = NHS * HP * NST;
    for (int e4 = F.gt; e4 < PER / 4; e4 += F.NGT) { const int e = e4 * 4, hd = e / (HP * NST);
        f32x4 st = {0.f, 0.f, 0.f, 0.f};
        for (int c = 0; c < NCH; ++c) {
            v2u o; o.x = cvtpk(st[0], st[1]); o.y = cvtpk(st[2], st[3]); *(v2u*)(SIN + (size_t)c * PER + e) = o;
            const f32x4 loc = *(const f32x4*)(SLOC + (size_t)c * PER + e);
            const float dec = __builtin_amdgcn_exp2f(ACL[(size_t)(c * CHK + CHK - 1) * 64 + hd]);
            st = st * dec + loc; } }
}
__device__ __forceinline__ void s3_unit(LAS unsigned char* ldsu, int c, int hd, const bf16* XBCC, const float* DT, const float* ACL, const bf16* SIN, const float* Dskip, bf16* Y, const int tid) {
    LAS char* lds = (LAS char*)ldsu;
    const int wid = __builtin_amdgcn_readfirstlane(tid >> 6), lane = tid & 63, r32 = lane & 31, hi = lane >> 5, g = hd >> 3;
    const int sr = tid >> 4, sc = (tid & 15) * 8;
    LAS char* Kt = lds; LAS char* Vt = lds + 16384;
    LAS float* acs = (LAS float*)(lds + 32768); LAS float* dts = acs + 64; LAS float* wsc = acs + 128 + wid * 32;
    const int vrb = fox::v_rd_base(lane), t0 = c * CHK, l0 = 32 * wid, trow = t0 + l0 + r32;
    bf16x8 qr[8];
#pragma unroll
    for (int d0 = 0; d0 < 8; ++d0) qr[d0] = *(const bf16x8*)(XBCC + (size_t)trow * CONVD + 5120 + g * 128 + d0 * 16 + hi * 8);
    const float acl = ACL[(size_t)trow * 64 + hd];
    f32x16 o[2]; o[0] = f32x16{}; o[1] = f32x16{};
    const bf16* sp = SIN + ((size_t)c * NHS + hd) * (HP * NST);
#pragma unroll
    for (int i = 0; i < 2; ++i)
#pragma unroll
        for (int ks = 0; ks < 8; ++ks) { const bf16x8 sf = *(const bf16x8*)(sp + (32 * i + r32) * NST + 16 * ks + 8 * hi); o[i] = __builtin_amdgcn_mfma_f32_32x32x16_bf16(qr[ks], sf, o[i], 0, 0, 0); }
    if (hi == 0) wsc[r32] = __builtin_amdgcn_exp2f(acl);
    LDS_WAIT();
#pragma unroll
    for (int i = 0; i < 2; ++i)
#pragma unroll
        for (int r = 0; r < 16; ++r) o[i][r] *= wsc[crow(r, hi)];
    for (int j = 0; j < 4; ++j) {
        const int s0 = t0 + 64 * j;
#pragma unroll
        for (int hh = 0; hh < 2; ++hh) { const int row = sr + 32 * hh; const size_t rb = (size_t)(s0 + row) * CONVD;
            *(LAS v4u*)(Kt + KSWZ(row, sc * 2)) = *(const v4u*)(XBCC + rb + 4096 + g * 128 + sc);
            if ((tid & 15) < 8) *(LAS v4u*)(Vt + fox::v_st(row, sc)) = *(const v4u*)(XBCC + rb + hd * 64 + sc); }
        if (tid < 64) { acs[tid] = ACL[(size_t)(s0 + tid) * 64 + hd]; dts[tid] = DT[(size_t)(s0 + tid) * 64 + hd]; }
        __syncthreads();
        if (j <= (wid >> 1)) {
            f32x16 p0 = f32x16{}, p1 = f32x16{};
#pragma unroll
            for (int d0 = 0; d0 < 8; ++d0) { const LAS char* a = Kt + KSWZ(r32, ((d0 & 3) * 16 + hi * 8) * 2) + (d0 >> 2) * 128;
                const bf16x8 b0 = *(const LAS bf16x8*)a, b1 = *(const LAS bf16x8*)(a + 32 * 256);
                p0 = __builtin_amdgcn_mfma_f32_32x32x16_bf16(b0, qr[d0], p0, 0, 0, 0);
                p1 = __builtin_amdgcn_mfma_f32_32x32x16_bf16(b1, qr[d0], p1, 0, 0, 0); }
            const int lrel = l0 + r32 - 64 * j;
#pragma unroll
            for (int jj = 0; jj < 4; ++jj) { const f32x4 a0 = *(const LAS f32x4*)(acs + 8 * jj + 4 * hi), a1 = *(const LAS f32x4*)(acs + 32 + 8 * jj + 4 * hi);
                const f32x4 e0 = *(const LAS f32x4*)(dts + 8 * jj + 4 * hi), e1 = *(const LAS f32x4*)(dts + 32 + 8 * jj + 4 * hi);
#pragma unroll
                for (int i = 0; i < 4; ++i) { const int r = 4 * jj + i, srel = 8 * jj + 4 * hi + i;
                    const float f0 = p0[r] * __builtin_amdgcn_exp2f(acl - a0[i]) * e0[i], f1 = p1[r] * __builtin_amdgcn_exp2f(acl - a1[i]) * e1[i];
                    p0[r] = (srel <= lrel) ? f0 : 0.f; p1[r] = (srel + 32 <= lrel) ? f1 : 0.f; } }
            bf16x8 pa0, pa1, pa2, pa3;
            FOX_PK4(p0, 0, pa0); FOX_PK4(p0, 8, pa1); FOX_PK4(p1, 0, pa2); FOX_PK4(p1, 8, pa3);
#pragma unroll
            for (int i = 0; i < 2; ++i) {
                o[i] = __builtin_amdgcn_mfma_f32_32x32x16_bf16(pa0, vfrag(Vt, vrb, i, 0), o[i], 0, 0, 0);
                o[i] = __builtin_amdgcn_mfma_f32_32x32x16_bf16(pa1, vfrag(Vt, vrb, i, 1), o[i], 0, 0, 0);
                o[i] = __builtin_amdgcn_mfma_f32_32x32x16_bf16(pa2, vfrag(Vt, vrb, i, 2), o[i], 0, 0, 0);
                o[i] = __builtin_amdgcn_mfma_f32_32x32x16_bf16(pa3, vfrag(Vt, vrb, i, 3), o[i], 0, 0, 0); }
        }
        __syncthreads();
    }
    const float Dh = Dskip[hd];
#pragma unroll
    for (int r = 0; r < 16; ++r) { const size_t row = (size_t)(t0 + l0 + crow(r, hi));
#pragma unroll
        for (int i = 0; i < 2; ++i) { const int col = hd * 64 + 32 * i + r32;
            const float xv = __builtin_bit_cast(float, (unsigned)XBCC[row * CONVD + col] << 16);
            const float v = o[i][r] + Dh * xv, vn = __shfl_xor(v, 1);
            if ((r32 & 1) == 0) *(unsigned*)(Y + row * DI + col) = cvtpk(v, vn); } }
}
__device__ __forceinline__ int v_st2(int k, int c) { const int kk = (k & ~0xC) | ((k & 4) << 1) | ((k & 8) >> 1); return ((kk >> 3) * 2 + (c >> 5)) * 512 + ((kk & 7) * 32 + (c & 31)) * 2; }
__device__ __forceinline__ bf16x8 vfrag2(const LAS char* tile, int vrb, int d0, int ks) {
    const s16x4 l = vtr(tile + vrb + d0 * 512 + ks * 2048), h = vtr(tile + vrb + d0 * 512 + ks * 2048 + 1024);
    return (bf16x8){l[0], l[1], l[2], l[3], h[0], h[1], h[2], h[3]};
}
__device__ __forceinline__ void s3g_unit(LAS unsigned char* ldsu, int c, int g, const bf16* XBCC, const float* DT, const float* ACL, const bf16* SIN, const float* Dskip, bf16* Y, const int tid, const int dbgm) {
    LAS char* lds = (LAS char*)ldsu;
    const int wid = __builtin_amdgcn_readfirstlane(tid >> 6), lane = tid & 63, r32 = lane & 31, hi = lane >> 5;
    LAS char* Kt = lds;
    LAS char* Vt = lds + 65536;
    LAS float* acs = (LAS float*)(lds + 98304); LAS float* dts = acs + 256; LAS float* wsc = acs + 512 + wid * 32;
    const int vrb = fox::v_rd_base(lane), t0 = c * CHK, l0 = 32 * wid, trow = t0 + l0 + r32;
#pragma unroll 2
    for (int i = 0; i < 8; ++i) { int pc = tid + 512 * i; asm volatile("" : "+v"(pc)); const int row = pc >> 4, sc = (pc & 15) * 8;
        *(LAS v4u*)(Kt + (row >> 6) * 16384 + KSWZ(row & 63, sc * 2)) = *(const v4u*)(XBCC + (unsigned)((t0 + row) * CONVD + 4096 + g * 128 + sc)); }
    asm volatile("" ::: "memory");
    bf16x8 qr[8];
#pragma unroll
    for (int d0 = 0; d0 < 8; ++d0) qr[d0] = *(const bf16x8*)(XBCC + (size_t)trow * CONVD + 5120 + g * 128 + d0 * 16 + hi * 8);
    const int ntile = (dbgm & 1) ? 0 : (wid >> 1) + 1;
    const unsigned xoff0 = (unsigned)((t0 + (tid >> 3)) * CONVD + (tid & 7) * 8);
    const int xl0 = ((tid >> 3) >> 6) * 8192 + v_st2((tid >> 3) & 63, (tid & 7) * 8);
    v4u xr[4]; float acn = 0.f, dtn = 0.f, acl;
    { const int hd = g * 8;
#pragma unroll
      for (int i = 0; i < 4; ++i) xr[i] = *(const v4u*)(XBCC + (xoff0 + (unsigned)(i * 64 * CONVD + hd * 64)));
      if (tid < 256) { acn = ACL[(size_t)(t0 + tid) * 64 + hd]; dtn = DT[(size_t)(t0 + tid) * 64 + hd]; }
      acl = ACL[(size_t)trow * 64 + hd]; }
#pragma unroll 1
    for (int hh = 0; hh < 8; ++hh) { const int hd = g * 8 + hh;
#pragma unroll
        for (int i = 0; i < 4; ++i) *(LAS v4u*)(Vt + i * 8192 + xl0) = xr[i];
        if (tid < 256) { acs[tid] = acn; dts[tid] = dtn; }
        const float acl_c = acl;
        f32x16 o[2]; o[0] = f32x16{}; o[1] = f32x16{};
        { const bf16* sp = SIN + ((size_t)c * NHS + hd) * (HP * NST);
#pragma unroll
          for (int i = 0; i < 2; ++i)
#pragma unroll
              for (int ks = 0; ks < 8; ++ks) { const bf16x8 sf = *(const bf16x8*)(sp + (32 * i + r32) * NST + 16 * ks + 8 * hi); o[i] = __builtin_amdgcn_mfma_f32_32x32x16_bf16(qr[ks], sf, o[i], 0, 0, 0); } }
        if (hi == 0) wsc[r32] = __builtin_amdgcn_exp2f(acl_c);
        if (hh < 7) { const int hn = hd + 1;
#pragma unroll
            for (int i = 0; i < 4; ++i) xr[i] = *(const v4u*)(XBCC + (xoff0 + (unsigned)(i * 64 * CONVD + hn * 64)));
            if (tid < 256) { acn = ACL[(size_t)(t0 + tid) * 64 + hn]; dtn = DT[(size_t)(t0 + tid) * 64 + hn]; }
            acl = ACL[(size_t)trow * 64 + hn]; }
        __syncthreads();
#pragma unroll
        for (int i = 0; i < 2; ++i)
#pragma unroll
            for (int r = 0; r < 16; ++r) o[i][r] *= wsc[crow(r, hi)];
#pragma unroll 1
        for (int j = 0; j < ntile; ++j) {
            const LAS char* Kj = Kt + j * 16384; const LAS char* Vj = Vt + j * 8192;
            f32x16 p0 = f32x16{}, p1 = f32x16{};
#pragma unroll
            for (int d0 = 0; d0 < 8; ++d0) { const LAS char* a = Kj + KSWZ(r32, ((d0 & 3) * 16 + hi * 8) * 2) + (d0 >> 2) * 128;
                const bf16x8 b0 = *(const LAS bf16x8*)a, b1 = *(const LAS bf16x8*)(a + 32 * 256);
                p0 = __builtin_amdgcn_mfma_f32_32x32x16_bf16(b0, qr[d0], p0, 0, 0, 0);
                p1 = __builtin_amdgcn_mfma_f32_32x32x16_bf16(b1, qr[d0], p1, 0, 0, 0); }
            const int lrel = l0 + r32 - 64 * j;
#pragma unroll
            for (int jj = 0; jj < 4; ++jj) { const f32x4 a0 = *(const LAS f32x4*)(acs + 64 * j + 8 * jj + 4 * hi), a1 = *(const LAS f32x4*)(acs + 64 * j + 32 + 8 * jj + 4 * hi);
                const f32x4 e0 = *(const LAS f32x4*)(dts + 64 * j + 8 * jj + 4 * hi), e1 = *(const LAS f32x4*)(dts + 64 * j + 32 + 8 * jj + 4 * hi);
#pragma unroll
                for (int i = 0; i < 4; ++i) { const int r = 4 * jj + i, srel = 8 * jj + 4 * hi + i;
                    const float f0 = p0[r] * __builtin_amdgcn_exp2f(acl_c - a0[i]) * e0[i], f1 = p1[r] * __builtin_amdgcn_exp2f(acl_c - a1[i]) * e1[i];
                    p0[r] = (srel <= lrel) ? f0 : 0.f; p1[r] = (srel + 32 <= lrel) ? f1 : 0.f; } }
            bf16x8 pa0, pa1, pa2, pa3;
            FOX_PK4(p0, 0, pa0); FOX_PK4(p0, 8, pa1); FOX_PK4(p1, 0, pa2); FOX_PK4(p1, 8, pa3);
#pragma unroll
            for (int i = 0; i < 2; ++i) {
                o[i] = __builtin_amdgcn_mfma_f32_32x32x16_bf16(pa0, vfrag2(Vj, vrb, i, 0), o[i], 0, 0, 0);
                o[i] = __builtin_amdgcn_mfma_f32_32x32x16_bf16(pa1, vfrag2(Vj, vrb, i, 1), o[i], 0, 0, 0);
                o[i] = __builtin_amdgcn_mfma_f32_32x32x16_bf16(pa2, vfrag2(Vj, vrb, i, 2), o[i], 0, 0, 0);
                o[i] = __builtin_amdgcn_mfma_f32_32x32x16_bf16(pa3, vfrag2(Vj, vrb, i, 3), o[i], 0, 0, 0); }
        }
        const float Dh = Dskip[hd];
        { int ln2 = lane; asm volatile("" : "+v"(ln2));
          const unsigned yo = (unsigned)((t0 + l0 + 4 * (ln2 >> 5)) * DI + hd * 64 + (ln2 & 31));
          const LAS char* xs = Vt + (wid >> 1) * 8192 + (wid & 1) * 4096 + (ln2 >> 5) * 1024 + (ln2 & 31) * 2;
#pragma unroll
          for (int r = 0; r < 16; ++r) { const int rr = crow(r, 0);
#pragma unroll
            for (int i = 0; i < 2; ++i) {
                const float xv = __builtin_bit_cast(float, (unsigned)(*(const LAS unsigned short*)(xs + ((r >> 3) & 1) * 2048 + i * 512 + ((r & 3) + 4 * ((r >> 2) & 1)) * 64)) << 16);
                const float v = o[i][r] + Dh * xv, vn = __shfl_xor(v, 1);
                if ((ln2 & 1) == 0) *(unsigned*)(Y + (yo + (unsigned)(rr * DI + 32 * i))) = cvtpk(v, vn); } } }
        __syncthreads();
    }
}

#define S3P_HALF(QR, RB, VT, ACS, DTS, ACLC, HD) do { \
        const int rb_ = (RB), l0_ = 32 * rb_; const float aclc_ = (ACLC); const LAS char* vt_ = (VT); const LAS float* acs_ = (ACS); const LAS float* dts_ = (DTS); \
        _Pragma("unroll") for (int i = 0; i < 2; ++i) _Pragma("unroll") for (int r = 0; r < 16; ++r) o[i][r] *= wsc[crow(r, hi)]; \
        const int ntile_ = (dbgm & 1) ? 0 : (rb_ >> 1) + 1; \
        _Pragma("unroll 1") for (int j = 0; j < ntile_; ++j) { \
            const LAS char* Kj = Kt + j * 16384; const LAS char* Vj = vt_ + j * 8192; \
            f32x16 p0 = f32x16{}, p1 = f32x16{}; \
            _Pragma("unroll") for (int d0 = 0; d0 < 8; ++d0) { const LAS char* a = Kj + KSWZ(r32, ((d0 & 3) * 16 + hi * 8) * 2) + (d0 >> 2) * 128; \
                const bf16x8 b0 = *(const LAS bf16x8*)a, b1 = *(const LAS bf16x8*)(a + 32 * 256); \
                p0 = __builtin_amdgcn_mfma_f32_32x32x16_bf16(b0, QR[d0], p0, 0, 0, 0); \
                p1 = __builtin_amdgcn_mfma_f32_32x32x16_bf16(b1, QR[d0], p1, 0, 0, 0); } \
            const int lrel = l0_ + r32 - 64 * j; \
            _Pragma("unroll") for (int jj = 0; jj < 4; ++jj) { const f32x4 a0 = *(const LAS f32x4*)(acs_ + 64 * j + 8 * jj + 4 * hi), a1 = *(const LAS f32x4*)(acs_ + 64 * j + 32 + 8 * jj + 4 * hi); \
                const f32x4 e0 = *(const LAS f32x4*)(dts_ + 64 * j + 8 * jj + 4 * hi), e1 = *(const LAS f32x4*)(dts_ + 64 * j + 32 + 8 * jj + 4 * hi); \
                _Pragma("unroll") for (int i = 0; i < 4; ++i) { const int r = 4 * jj + i, srel = 8 * jj + 4 * hi + i; \
                    const float f0 = p0[r] * __builtin_amdgcn_exp2f(aclc_ - a0[i]) * e0[i], f1 = p1[r] * __builtin_amdgcn_exp2f(aclc_ - a1[i]) * e1[i]; \
                    p0[r] = (srel <= lrel) ? f0 : 0.f; p1[r] = (srel + 32 <= lrel) ? f1 : 0.f; } } \
            bf16x8 pa0, pa1, pa2, pa3; \
            FOX_PK4(p0, 0, pa0); FOX_PK4(p0, 8, pa1); FOX_PK4(p1, 0, pa2); FOX_PK4(p1, 8, pa3); \
            _Pragma("unroll") for (int i = 0; i < 2; ++i) { \
                o[i] = __builtin_amdgcn_mfma_f32_32x32x16_bf16(pa0, vfrag2(Vj, vrb, i, 0), o[i], 0, 0, 0); \
                o[i] = __builtin_amdgcn_mfma_f32_32x32x16_bf16(pa1, vfrag2(Vj, vrb, i, 1), o[i], 0, 0, 0); \
                o[i] = __builtin_amdgcn_mfma_f32_32x32x16_bf16(pa2, vfrag2(Vj, vrb, i, 2), o[i], 0, 0, 0); \
                o[i] = __builtin_amdgcn_mfma_f32_32x32x16_bf16(pa3, vfrag2(Vj, vrb, i, 3), o[i], 0, 0, 0); } \
        } \
        const float Dh = Dskip[(HD)]; \
        { int ln2 = lane; asm volatile("" : "+v"(ln2)); \
          const unsigned yo = (unsigned)((t0 + l0_ + 4 * (ln2 >> 5)) * DI + (HD) * 64 + (ln2 & 31)); \
          const LAS char* xs = vt_ + (rb_ >> 1) * 8192 + (rb_ & 1) * 4096 + (ln2 >> 5) * 1024 + (ln2 & 31) * 2; \
          _Pragma("unroll") for (int r = 0; r < 16; ++r) { const int rr = crow(r, 0); \
            _Pragma("unroll") for (int i = 0; i < 2; ++i) { \
                const float xv = __builtin_bit_cast(float, (unsigned)(*(const LAS unsigned short*)(xs + ((r >> 3) & 1) * 2048 + i * 512 + ((r & 3) + 4 * ((r >> 2) & 1)) * 64)) << 16); \
                const float v = o[i][r] + Dh * xv, vn = __shfl_xor(v, 1); \
                if ((ln2 & 1) == 0) *(unsigned*)(Y + (yo + (unsigned)(rr * DI + 32 * i))) = cvtpk(v, vn); } } } \
    } while (0)
#define S3P_OINIT(QR, HD) do { o[0] = f32x16{}; o[1] = f32x16{}; const bf16* sp = SIN + ((size_t)c * NHS + (HD)) * (HP * NST); \
        _Pragma("unroll") for (int i = 0; i < 2; ++i) _Pragma("unroll") for (int ks = 0; ks < 8; ++ks) { const bf16x8 sf = *(const bf16x8*)(sp + (32 * i + r32) * NST + 16 * ks + 8 * hi); o[i] = __builtin_amdgcn_mfma_f32_32x32x16_bf16(QR[ks], sf, o[i], 0, 0, 0); } } while (0)
__device__ __forceinline__ void s3p_unit(LAS unsigned char* ldsu, int c, int g, const bf16* XBCC, const float* DT, const float* ACL, const bf16* SIN, const float* Dskip, bf16* Y, const int tid, const int dbgm) {
    LAS char* lds = (LAS char*)ldsu;
    const int wid = __builtin_amdgcn_readfirstlane(tid >> 6), lane = tid & 63, r32 = lane & 31, hi = lane >> 5;
    LAS char* Kt = lds;
    LAS char* Vt = lds + 65536;
    LAS float* acs = (LAS float*)(lds + 132096); LAS float* dts = acs + 512; LAS float* wsc = acs + 1024 + wid * 32;
    const int vrb = fox::v_rd_base(lane), t0 = c * CHK, rbA = wid, rbB = 7 - wid;
#pragma unroll 2
    for (int i = 0; i < 8; ++i) { int pc = tid + 512 * i; asm volatile("" : "+v"(pc)); const int row = pc >> 4, sc = (pc & 15) * 8;
        *(LAS v4u*)(Kt + (row >> 6) * 16384 + KSWZ(row & 63, sc * 2)) = *(const v4u*)(XBCC + (unsigned)((t0 + row) * CONVD + 4096 + g * 128 + sc)); }
    asm volatile("" ::: "memory");
    bf16x8 qA[8], qB[8];
    const int trowA = t0 + 32 * rbA + r32, trowB = t0 + 32 * rbB + r32;
#pragma unroll
    for (int d0 = 0; d0 < 8; ++d0) { qA[d0] = *(const bf16x8*)(XBCC + (size_t)trowA * CONVD + 5120 + g * 128 + d0 * 16 + hi * 8); qB[d0] = *(const bf16x8*)(XBCC + (size_t)trowB * CONVD + 5120 + g * 128 + d0 * 16 + hi * 8); }
    const unsigned xoff0 = (unsigned)((t0 + (tid >> 3)) * CONVD + (tid & 7) * 8);
    const int xl0 = ((tid >> 3) >> 6) * 8192 + v_st2((tid >> 3) & 63, (tid & 7) * 8);
    const int hsel = wid >> 2;
#define S3P_EL(v) int v = lane; asm volatile("" : "+v"(v)); v += (wid & 3) * 64
    v4u xr[8]; float acn, dtn, aclA, aclB;
    { const int hd = g * 8;
#pragma unroll
      for (int i = 0; i < 4; ++i) { xr[i] = *(const v4u*)(XBCC + (xoff0 + (unsigned)(i * 64 * CONVD + hd * 64))); xr[4 + i] = *(const v4u*)(XBCC + (xoff0 + (unsigned)(i * 64 * CONVD + (hd + 1) * 64))); }
      S3P_EL(el); acn = ACL[(unsigned)((t0 + el) * 64 + hd + hsel)]; dtn = DT[(unsigned)((t0 + el) * 64 + hd + hsel)];
      aclA = ACL[(unsigned)(trowA * 64 + hd)]; aclB = ACL[(unsigned)(trowB * 64 + hd + 1)]; }
#pragma unroll 1
    for (int pp = 0; pp < 4; ++pp) { const int hA = g * 8 + 2 * pp, hB = hA + 1;
#pragma unroll
        for (int i = 0; i < 4; ++i) { *(LAS v4u*)(Vt + i * 8192 + xl0) = xr[i]; *(LAS v4u*)(Vt + 32768 + i * 8192 + xl0) = xr[4 + i]; }
        { S3P_EL(el); acs[hsel * 256 + el] = acn; dts[hsel * 256 + el] = dtn; }
        const float aclA_c = aclA, aclB_c = aclB;
        f32x16 o[2];
        S3P_OINIT(qA, hA);
        if (hi == 0) wsc[r32] = __builtin_amdgcn_exp2f(aclA_c);
        if (pp < 3) { const int hn = hA + 2;
#pragma unroll
            for (int i = 0; i < 4; ++i) { xr[i] = *(const v4u*)(XBCC + (xoff0 + (unsigned)(i * 64 * CONVD + hn * 64))); xr[4 + i] = *(const v4u*)(XBCC + (xoff0 + (unsigned)(i * 64 * CONVD + (hn + 1) * 64))); }
            S3P_EL(el); acn = ACL[(unsigned)((t0 + el) * 64 + hn + hsel)]; dtn = DT[(unsigned)((t0 + el) * 64 + hn + hsel)];
            aclA = ACL[(unsigned)(trowA * 64 + hn)]; aclB = ACL[(unsigned)(trowB * 64 + hn + 1)]; }
        __syncthreads();
        S3P_HALF(qA, rbA, Vt, acs, dts, aclA_c, hA);
        S3P_OINIT(qB, hB);
        if (hi == 0) wsc[r32] = __builtin_amdgcn_exp2f(aclB_c);
        LDS_WAIT(); asm volatile("" ::: "memory");
        S3P_HALF(qB, rbB, Vt + 32768, acs + 256, dts + 256, aclB_c, hB);
        __syncthreads();
    }
}
#undef S3P_HALF
#undef S3P_EL
#undef S3P_OINIT
}
namespace peer {
using fox::crow;
__device__ __forceinline__ void top16_of_128(float a0, float a1, int lane, float& ts, int& ti) {
    ts = 0.f; ti = 0;
    for (int r = 0; r < 16; ++r) {
        const float m = wave_max(fmaxf(a0, a1));
        const unsigned long long b0 = __ballot(a0 == m);
        int idx;
        if (b0) { const int l = __ffsll((long long)b0) - 1; idx = l; if (lane == l) a0 = -__builtin_inff(); }
        else { const unsigned long long b1 = __ballot(a1 == m); const int l = __ffsll((long long)b1) - 1; idx = 64 + l; if (lane == l) a1 = -__builtin_inff(); }
        if (lane == r) { ts = m; ti = idx; }
    }
}
__device__ __forceinline__ void topk_unit(LAS unsigned char* ldsu, int tt, int h, const bf16* PQ, const bf16* SK, int* EIDX, float* GATE, const int tid, const float* SKF) {
    LAS float* scv = (LAS float*)ldsu;
    const int wid = __builtin_amdgcn_readfirstlane(tid >> 6), lane = tid & 63, r32 = lane & 31, hi = lane >> 5;
    const int t0 = tt * 32;
#if DBG_SCORES
    for (int i = tid; i < 32 * 2 * 128; i += 512) { const int key = i & 127, cc = (i >> 7) & 1, tok = i >> 8;
        const bf16* qp = PQ + (size_t)(t0 + tok) * DM + h * 256 + cc * 128; const float* kp = SKF + ((size_t)(h * 2 + cc) * NKEY + key) * 128;
        float s = 0.f; for (int d = 0; d < 128; ++d) s += __builtin_bit_cast(float, (unsigned)qp[d] << 16) * kp[d];
        scv[(tok * 2 + cc) * 128 + key] = s; }
#else
    { const int cc = wid >> 2, kb = wid & 3;
      f32x16 acc = f32x16{};
      const bf16* qp = PQ + (size_t)(t0 + r32) * DM + h * 256 + cc * 128 + 8 * hi;
      const bf16* kp = SK + ((size_t)(h * 2 + cc) * NKEY + 32 * kb + r32) * 128 + 8 * hi;
#pragma unroll
      for (int ks = 0; ks < 8; ++ks) { const bf16x8 qa = *(const bf16x8*)(qp + 16 * ks), kf = *(const bf16x8*)(kp + 16 * ks); acc = __builtin_amdgcn_mfma_f32_32x32x16_bf16(qa, kf, acc, 0, 0, 0); }
#pragma unroll
      for (int r = 0; r < 16; ++r) scv[(crow(r, hi) * 2 + cc) * 128 + 32 * kb + r32] = acc[r]; }
#endif
    __syncthreads();
    for (int q = 0; q < 4; ++q) { const int tl = wid * 4 + q, t = t0 + tl;
        const LAS float* s1 = scv + (tl * 2) * 128; const LAS float* s2 = s1 + 128;
#if DBG_BRUTE
        float tv = 0.f; int te = 0; float prev = __builtin_inff();
        for (int r = 0; r < 16; ++r) {
            float bv = -__builtin_inff(); int bi = 0;
            for (int kk = 0; kk < 2; ++kk) { const int k1 = lane + 64 * kk; const float a = s1[k1];
                for (int k2 = 0; k2 < 128; ++k2) { const float v = a + s2[k2]; if (v < prev && v > bv) { bv = v; bi = k1 * 128 + k2; } } }
            const float m = wave_max(bv);
            const unsigned long long b = __ballot(bv == m); const int l = __ffsll((long long)b) - 1; const int e = __shfl(bi, l);
            if (lane == r) { tv = m; te = e; }
            prev = m;
        }
#else
        float ts1, ts2; int ti1, ti2;
        top16_of_128(s1[lane], s1[lane + 64], lane, ts1, ti1);
        top16_of_128(s2[lane], s2[lane + 64], lane, ts2, ti2);
        const float sj = __shfl(ts2, lane & 15); const int ij = __shfl(ti2, lane & 15);
        float cv[4]; int ci[4];
#pragma unroll
        for (int k = 0; k < 4; ++k) { const int i = (lane >> 4) + 4 * k; cv[k] = __shfl(ts1, i) + sj; ci[k] = __shfl(ti1, i) * NKEY + ij; }
        float tv = 0.f; int te = 0;
        for (int r = 0; r < 16; ++r) {
            const float m = wave_max(fmaxf(fmaxf(cv[0], cv[1]), fmaxf(cv[2], cv[3])));
            int e = 0; bool found = false;
#pragma unroll
            for (int k = 0; k < 4; ++k) { if (!found) { const unsigned long long b = __ballot(cv[k] == m);
                    if (b) { const int l = __ffsll((long long)b) - 1; e = __shfl(ci[k], l); if (lane == l) cv[k] = -__builtin_inff(); found = true; } } }
            if (lane == r) { tv = m; te = e; }
        }
#endif
        const float mx = __shfl(tv, 0);
        const float ex = lane < 16 ? __expf(tv - mx) : 0.f;
        const float den = wave_sum(ex);
        if (lane < 16) { EIDX[(size_t)t * 128 + h * 16 + lane] = te; GATE[(size_t)t * 128 + h * 16 + lane] = ex / den; }
    }
    __syncthreads();
}
__device__ __forceinline__ unsigned f2key(float s) { const unsigned u = __float_as_uint(s); return u ^ (unsigned)(((int)u >> 31) | (int)0x80000000); }
__device__ __forceinline__ float key2f(unsigned k) { const unsigned u = k ^ (unsigned)((~((int)k >> 31)) | (int)0x80000000); return __uint_as_float(u); }
__device__ __forceinline__ unsigned umin_(unsigned a, unsigned b) { return a < b ? a : b; }
__device__ __forceinline__ unsigned umax_(unsigned a, unsigned b) { return a > b ? a : b; }
__device__ __forceinline__ void bsort16(unsigned (&a)[16]) {
#pragma unroll
    for (int k = 2; k <= 16; k <<= 1)
#pragma unroll
        for (int j = k >> 1; j > 0; j >>= 1)
#pragma unroll
            for (int i = 0; i < 16; ++i) { const int l = i ^ j; if (l > i) { const bool up = (i & k) == 0; const unsigned lo = umin_(a[i], a[l]), hi = umax_(a[i], a[l]); a[i] = up ? lo : hi; a[l] = up ? hi : lo; } }
}
__device__ __forceinline__ void bmerge16(unsigned (&a)[16]) {
#pragma unroll
    for (int j = 8; j > 0; j >>= 1)
#pragma unroll
        for (int i = 0; i < 16; ++i) { const int l = i ^ j; if (l > i) { const unsigned lo = umin_(a[i], a[l]), hi = umax_(a[i], a[l]); a[i] = lo; a[l] = hi; } }
}
__device__ __forceinline__ void mprune16(unsigned (&r)[16], const unsigned (&g)[16]) {
#pragma unroll
    for (int i = 0; i < 16; ++i) r[i] = umax_(r[i], g[15 - i]);
    bmerge16(r);
}
__device__ __forceinline__ void pair_top16(unsigned (&r)[16]) {
    unsigned a[16], b[16];
#pragma unroll
    for (int i = 0; i < 16; ++i) { auto rr = __builtin_amdgcn_permlane32_swap(r[i], r[i], false, false); a[i] = rr[0]; b[i] = rr[1]; }
#pragma unroll
    for (int i = 0; i < 16; ++i) r[i] = umax_(a[i], b[15 - i]);
}
__device__ __forceinline__ void topk2_unit(LAS unsigned char* ldsw  , int tt, int h, const bf16* PQ, const bf16* SK, int* EIDX, float* GATE) {
#define TK_LANE() ([]() { unsigned m_ = ~0u; asm volatile("" : "+s"(m_)); return (int)__builtin_amdgcn_mbcnt_hi(m_, __builtin_amdgcn_mbcnt_lo(m_, 0u)); }())
    const int t0 = tt * 32; const int hi = TK_LANE() >> 5;
    unsigned S[2][16];
#pragma unroll
    for (int cc = 0; cc < 2; ++cc) {
        f32x16 acc[4];
#pragma unroll
        for (int kb = 0; kb < 4; ++kb) acc[kb] = f32x16{};
        const int r32a = TK_LANE() & 31;
        const bf16* qp = PQ + (size_t)(t0 + r32a) * DM + h * 256 + cc * 128 + 8 * hi;
        const bf16* kp = SK + ((size_t)(h * 2 + cc) * NKEY + r32a) * 128 + 8 * hi;
#pragma unroll 2
        for (int ks = 0; ks < 8; ++ks) { const bf16x8 qf = *(const bf16x8*)(qp + 16 * ks);
#pragma unroll
            for (int kb = 0; kb < 4; ++kb) { const bf16x8 kf = *(const bf16x8*)(kp + (size_t)kb * 32 * 128 + 16 * ks); acc[kb] = __builtin_amdgcn_mfma_f32_32x32x16_bf16(kf, qf, acc[kb], 0, 0, 0); } }
        const unsigned hi4 = 4u * hi;
        unsigned R[16];
#pragma unroll
        for (int kb = 0; kb < 4; ++kb) { unsigned g[16];
#pragma unroll
            for (int r = 0; r < 16; ++r) g[r] = (f2key(acc[kb][r]) & 0xFFFFFF80u) | (unsigned)(32 * kb + (r & 3) + 8 * (r >> 2)) | hi4;
            bsort16(g);
            if (kb == 0) {
#pragma unroll
                for (int i = 0; i < 16; ++i) R[i] = g[i]; }
            else mprune16(R, g); }
        pair_top16(R);
#pragma unroll
        for (int i = 0; i < 16; ++i) S[cc][i] = R[i];
        SBAR();
    }
    { LAS unsigned* tb = (LAS unsigned*)ldsw + (TK_LANE() & 31) * 8 + hi * 4;
#pragma unroll
      for (int w4 = 0; w4 < 4; ++w4) { unsigned pk = 0;
#pragma unroll
          for (int b = 0; b < 4; ++b) { const unsigned kx = hi ? S[1][4 * w4 + b] : S[0][4 * w4 + b]; pk |= (kx & 127u) << (8 * b); }
          tb[w4] = pk; } }
    float f2[16];
#pragma unroll
    for (int j = 0; j < 16; ++j) f2[j] = key2f(S[1][j] & 0xFFFFFF80u);
    const unsigned hi7 = 128u * hi;
    unsigned R[16];
#pragma unroll
    for (int i2 = 0; i2 < 8; ++i2) { const float f1 = key2f((hi ? S[0][8 + i2] : S[0][i2]) & 0xFFFFFF80u); unsigned g[16];
#pragma unroll
        for (int j = 0; j < 16; ++j) g[j] = (f2key(f1 + f2[j]) & 0xFFFFFF00u) | (unsigned)(16 * i2 + j) | hi7;
        bsort16(g);
        if (i2 == 0) {
#pragma unroll
            for (int i = 0; i < 16; ++i) R[i] = g[i]; }
        else mprune16(R, g); }
    pair_top16(R);
    float v[16]; float mx = -__builtin_inff();
#pragma unroll
    for (int i = 0; i < 16; ++i) { v[i] = key2f(R[i] & 0xFFFFFF00u); mx = fmaxf(mx, v[i]); }
    float den = 0.f;
#pragma unroll
    for (int i = 0; i < 16; ++i) { v[i] = __expf(v[i] - mx); den += v[i]; }
    const float rden = 1.f / den;
    LDS_WAIT();
    const int r32 = TK_LANE() & 31;
    const LAS unsigned char* tbb = (const LAS unsigned char*)ldsw + r32 * 32;
    int eo[8]; float go[8];
#pragma unroll
    for (int k = 0; k < 8; ++k) { const unsigned w = hi ? R[8 + k] : R[k]; const unsigned code = w & 255u;
        eo[k] = (int)tbb[code >> 4] * NKEY + (int)tbb[16 + (code & 15u)]; go[k] = (hi ? v[8 + k] : v[k]) * rden; }
    const size_t ob = (size_t)(t0 + r32) * 128 + h * 16 + 8 * hi;
    *(v4u*)(EIDX + ob) = (v4u){(unsigned)eo[0], (unsigned)eo[1], (unsigned)eo[2], (unsigned)eo[3]}; *(v4u*)(EIDX + ob + 4) = (v4u){(unsigned)eo[4], (unsigned)eo[5], (unsigned)eo[6], (unsigned)eo[7]};
    *(f32x4*)(GATE + ob) = (f32x4){go[0], go[1], go[2], go[3]}; *(f32x4*)(GATE + ob + 4) = (f32x4){go[4], go[5], go[6], go[7]};
    LDS_WAIT();
}
#undef TK_LANE
__device__ __forceinline__ void expert_phase(const Frame& F, float* H, bf16* XN, const bf16* U, const bf16* V, const int* EIDX, const float* GATE, const float* nw, const bool dbg_skip, const bool dry, const float* UF, const float* VF) {
    const int lane = F.lane;
    for (int t = F.gw; t < SEQ; t += F.NGW) {
        v4u xr[4];
#pragma unroll
        for (int j = 0; j < 4; ++j) xr[j] = *(const v4u*)(XN + (size_t)t * DM + lane * 8 + 512 * j);
        const int e_lo = EIDX[(size_t)t * 128 + lane], e_hi = EIDX[(size_t)t * 128 + 64 + lane];
        const float g_lo = GATE[(size_t)t * 128 + lane], g_hi = GATE[(size_t)t * 128 + 64 + lane];
        float acc[32];
#pragma unroll
        for (int i = 0; i < 32; ++i) acc[i] = 0.f;
        for (int e0 = dbg_skip ? 128 : 0; e0 < 128; e0 += 4) {
            v4u ur[4][4], vr[4][4]; float gg[4];
#pragma unroll
            for (int q = 0; q < 4; ++q) { const int e = e0 + q; const int ei = __builtin_amdgcn_readlane(e < 64 ? e_lo : e_hi, e & 63);
                gg[q] = __builtin_bit_cast(float, __builtin_amdgcn_readlane(__builtin_bit_cast(int, e < 64 ? g_lo : g_hi), e & 63));
#if DBG_F32TAB
                const float* up = UF + (size_t)ei * DM + lane * 8; const float* vp = VF + (size_t)ei * DM + lane * 8;
#pragma unroll
                for (int j = 0; j < 4; ++j) { const f32x4 a0 = *(const f32x4*)(up + 512 * j), a1 = *(const f32x4*)(up + 512 * j + 4), b0 = *(const f32x4*)(vp + 512 * j), b1 = *(const f32x4*)(vp + 512 * j + 4);
                    ur[q][j] = (v4u){cvtpk(a0[0], a0[1]), cvtpk(a0[2], a0[3]), cvtpk(a1[0], a1[1]), cvtpk(a1[2], a1[3])}; vr[q][j] = (v4u){cvtpk(b0[0], b0[1]), cvtpk(b0[2], b0[3]), cvtpk(b1[0], b1[1]), cvtpk(b1[2], b1[3])}; } }
#else
                const bf16* up = U + (size_t)ei * DM + lane * 8; const bf16* vp = V + (size_t)ei * DM + lane * 8;
#pragma unroll
                for (int j = 0; j < 4; ++j) { ur[q][j] = *(const v4u*)(up + 512 * j); vr[q][j] = *(const v4u*)(vp + 512 * j); } }
#endif
#pragma unroll
            for (int q = 0; q < 4; ++q) { float d = 0.f;
#pragma unroll
                for (int j = 0; j < 4; ++j) {
                    d += bflo(ur[q][j].x) * bflo(xr[j].x) + bfhi(ur[q][j].x) * bfhi(xr[j].x);
                    d += bflo(ur[q][j].y) * bflo(xr[j].y) + bfhi(ur[q][j].y) * bfhi(xr[j].y);
                    d += bflo(ur[q][j].z) * bflo(xr[j].z) + bfhi(ur[q][j].z) * bfhi(xr[j].z);
                    d += bflo(ur[q][j].w) * bflo(xr[j].w) + bfhi(ur[q][j].w) * bfhi(xr[j].w); }
                d = wave_sum(d);
                const float a = gg[q] * 0.5f * d * (1.f + erff(d * 0.70710678118654752f));
#pragma unroll
                for (int j = 0; j < 4; ++j) {
                    acc[8 * j + 0] += a * bflo(vr[q][j].x); acc[8 * j + 1] += a * bfhi(vr[q][j].x); acc[8 * j + 2] += a * bflo(vr[q][j].y); acc[8 * j + 3] += a * bfhi(vr[q][j].y);
                    acc[8 * j + 4] += a * bflo(vr[q][j].z); acc[8 * j + 5] += a * bfhi(vr[q][j].z); acc[8 * j + 6] += a * bflo(vr[q][j].w); acc[8 * j + 7] += a * bfhi(vr[q][j].w); } }
        }
        f32x4 hv[8]; row_load(H + (size_t)t * DM, lane, hv);
#pragma unroll
        for (int j = 0; j < 8; ++j) { hv[j][0] += acc[4 * j]; hv[j][1] += acc[4 * j + 1]; hv[j][2] += acc[4 * j + 2]; hv[j][3] += acc[4 * j + 3]; }
#pragma unroll
        for (int j = 0; j < 4; ++j) { if (!dry) { *(f32x4*)(H + (size_t)t * DM + lane * 8 + 512 * j) = hv[2 * j]; *(f32x4*)(H + (size_t)t * DM + lane * 8 + 512 * j + 4) = hv[2 * j + 1]; } }
        const float rstd = row_rstd(hv);
        if (!dry) row_store_norm(hv, rstd, nw, XN + (size_t)t * DM, lane);
    }
}
typedef float f2v __attribute__((ext_vector_type(2)));
__device__ __forceinline__ void tab_fp8_phase(const Frame& F, const float* src, unsigned char* dst, float* scl, int rows) {
    const int lane = F.lane;
    for (int r = F.gw; r < rows; r += F.NGW) { const float* row = src + (size_t)r * DM + 16 * lane;
        f32x4 v[8]; float am = 0.f;
#pragma unroll
        for (int j = 0; j < 2; ++j)
#pragma unroll
            for (int q4 = 0; q4 < 4; ++q4) { const f32x4 x = *(const f32x4*)(row + 1024 * j + 4 * q4); v[4 * j + q4] = x; am = fmaxf(am, fmaxf(fmaxf(fabsf(x[0]), fabsf(x[1])), fmaxf(fabsf(x[2]), fabsf(x[3])))); }
        am = wave_max(am);
        const float sc = am > 0.f ? 224.f / am : 1.f;
#pragma unroll
        for (int j = 0; j < 2; ++j) { v4u w;
#pragma unroll
            for (int q4 = 0; q4 < 4; ++q4) { const f32x4 x = v[4 * j + q4] * sc; int p = __builtin_amdgcn_cvt_pk_fp8_f32(x[0], x[1], 0, false); p = __builtin_amdgcn_cvt_pk_fp8_f32(x[2], x[3], p, true); w[q4] = (unsigned)p; }
            *(v4u*)(dst + (size_t)r * DM + 16 * lane + 1024 * j) = w; }
        if (lane == 0) scl[r] = am > 0.f ? am * (1.f / 224.f) : 1.f;
    }
}
__device__ __forceinline__ void expert8_phase(const Frame& F, float* H, bf16* XN, const unsigned char* U8, const unsigned char* V8, const float* SU, const float* SV, const int* EIDX, const float* GATE, const float* nw, const bool dry) {
    const int lane = F.lane;
    for (int t = F.gw; t < SEQ; t += F.NGW) {
        float xf[32];
#pragma unroll
        for (int j = 0; j < 2; ++j) { const v4u a = *(const v4u*)(XN + (size_t)t * DM + 16 * lane + 1024 * j), b = *(const v4u*)(XN + (size_t)t * DM + 16 * lane + 1024 * j + 8);
            xf[16 * j + 0] = bflo(a.x); xf[16 * j + 1] = bfhi(a.x); xf[16 * j + 2] = bflo(a.y); xf[16 * j + 3] = bfhi(a.y); xf[16 * j + 4] = bflo(a.z); xf[16 * j + 5] = bfhi(a.z); xf[16 * j + 6] = bflo(a.w); xf[16 * j + 7] = bfhi(a.w);
            xf[16 * j + 8] = bflo(b.x); xf[16 * j + 9] = bfhi(b.x); xf[16 * j + 10] = bflo(b.y); xf[16 * j + 11] = bfhi(b.y); xf[16 * j + 12] = bflo(b.z); xf[16 * j + 13] = bfhi(b.z); xf[16 * j + 14] = bflo(b.w); xf[16 * j + 15] = bfhi(b.w); }
        const int e_lo = EIDX[(size_t)t * 128 + lane], e_hi = EIDX[(size_t)t * 128 + 64 + lane];
        const float g_lo = GATE[(size_t)t * 128 + lane], g_hi = GATE[(size_t)t * 128 + 64 + lane];
        float acc[32];
#pragma unroll
        for (int i = 0; i < 32; ++i) acc[i] = 0.f;
        for (int e0 = 0; e0 < 128; e0 += 4) {
            v4u ur[4][2], vr[4][2]; float gg[4], su[4], sv[4];
#pragma unroll
            for (int q = 0; q < 4; ++q) { const int e = e0 + q; const int ei = __builtin_amdgcn_readlane(e < 64 ? e_lo : e_hi, e & 63);
                gg[q] = __builtin_bit_cast(float, __builtin_amdgcn_readlane(__builtin_bit_cast(int, e < 64 ? g_lo : g_hi), e & 63));
                su[q] = SU[ei]; sv[q] = SV[ei];
                const unsigned char* up = U8 + (size_t)ei * DM + 16 * lane; const unsigned char* vp = V8 + (size_t)ei * DM + 16 * lane;
#pragma unroll
                for (int j = 0; j < 2; ++j) { ur[q][j] = *(const v4u*)(up + 1024 * j); vr[q][j] = *(const v4u*)(vp + 1024 * j); } }
#pragma unroll
            for (int q = 0; q < 4; ++q) { float d = 0.f;
#pragma unroll
                for (int j = 0; j < 2; ++j)
#pragma unroll
                    for (int w = 0; w < 4; ++w) { const f2v lo = __builtin_amdgcn_cvt_pk_f32_fp8((int)ur[q][j][w], false), hi2 = __builtin_amdgcn_cvt_pk_f32_fp8((int)ur[q][j][w], true);
                        d += lo.x * xf[16 * j + 4 * w] + lo.y * xf[16 * j + 4 * w + 1]; d += hi2.x * xf[16 * j + 4 * w + 2] + hi2.y * xf[16 * j + 4 * w + 3]; }
                d = wave_sum(d) * su[q];
                const float a = gg[q] * sv[q] * 0.5f * d * (1.f + erff(d * 0.70710678118654752f));
#pragma unroll
                for (int j = 0; j < 2; ++j)
#pragma unroll
                    for (int w = 0; w < 4; ++w) { const f2v lo = __builtin_amdgcn_cvt_pk_f32_fp8((int)vr[q][j][w], false), hi2 = __builtin_amdgcn_cvt_pk_f32_fp8((int)vr[q][j][w], true);
                        acc[16 * j + 4 * w] += a * lo.x; acc[16 * j + 4 * w + 1] += a * lo.y; acc[16 * j + 4 * w + 2] += a * hi2.x; acc[16 * j + 4 * w + 3] += a * hi2.y; } }
        }
        float* hrow = H + (size_t)t * DM + 16 * lane; float ss = 0.f;
#pragma unroll
        for (int j = 0; j < 2; ++j)
#pragma unroll
            for (int q4 = 0; q4 < 4; ++q4) { f32x4 hv = *(const f32x4*)(hrow + 1024 * j + 4 * q4);
                hv[0] += acc[16 * j + 4 * q4]; hv[1] += acc[16 * j + 4 * q4 + 1]; hv[2] += acc[16 * j + 4 * q4 + 2]; hv[3] += acc[16 * j + 4 * q4 + 3];
                acc[16 * j + 4 * q4] = hv[0]; acc[16 * j + 4 * q4 + 1] = hv[1]; acc[16 * j + 4 * q4 + 2] = hv[2]; acc[16 * j + 4 * q4 + 3] = hv[3];
                ss += (hv[0] * hv[0] + hv[1] * hv[1]) + (hv[2] * hv[2] + hv[3] * hv[3]);
                if (!dry) *(f32x4*)(hrow + 1024 * j + 4 * q4) = hv; }
        const float rstd = 1.f / sqrtf(wave_sum(ss) * (1.f / DM) + RMS_EPS);
        if (!dry) {
#pragma unroll
            for (int j = 0; j < 2; ++j)
#pragma unroll
                for (int hf = 0; hf < 2; ++hf) { const f32x4 w0 = *(const f32x4*)(nw + 16 * lane + 1024 * j + 8 * hf), w1 = *(const f32x4*)(nw + 16 * lane + 1024 * j + 8 * hf + 4); const int b = 16 * j + 8 * hf;
                    v4u o; o.x = cvtpk(acc[b] * rstd * w0[0], acc[b + 1] * rstd * w0[1]); o.y = cvtpk(acc[b + 2] * rstd * w0[2], acc[b + 3] * rstd * w0[3]);
                    o.z = cvtpk(acc[b + 4] * rstd * w1[0], acc[b + 5] * rstd * w1[1]); o.w = cvtpk(acc[b + 6] * rstd * w1[2], acc[b + 7] * rstd * w1[3]);
                    *(v4u*)(XN + (size_t)t * DM + 16 * lane + 1024 * j + 8 * hf) = o; } }
    }
}
constexpr int TROW = 2048;
__device__ __forceinline__ void tab_fp4_row(const f32x4 (&v)[8], unsigned char* dst, float* scl, int r, int lane) {
    float am = 0.f;
#pragma unroll
    for (int i = 0; i < 8; ++i) am = fmaxf(am, fmaxf(fmaxf(fabsf(v[i][0]), fabsf(v[i][1])), fmaxf(fabsf(v[i][2]), fabsf(v[i][3]))));
    am = wave_max(am);
    const float sc = am > 0.f ? 6.f / am : 1.f;
    v4u w;
#pragma unroll
    for (int j = 0; j < 4; ++j) { const f32x4 a = v[2 * j] * sc, b = v[2 * j + 1] * sc; unsigned p = 0;
        p = __builtin_amdgcn_cvt_scalef32_pk_fp4_f32(p, a[0], a[1], 1.0f, 0); p = __builtin_amdgcn_cvt_scalef32_pk_fp4_f32(p, a[2], a[3], 1.0f, 1);
        p = __builtin_amdgcn_cvt_scalef32_pk_fp4_f32(p, b[0], b[1], 1.0f, 2); p = __builtin_amdgcn_cvt_scalef32_pk_fp4_f32(p, b[2], b[3], 1.0f, 3); w[j] = p; }
    *(v4u*)(dst + (size_t)r * TROW + 16 * lane) = w;
    if (lane == 0) scl[r] = am > 0.f ? am * (1.f / 6.f) : 1.f;
}
__device__ __forceinline__ void tab_fp4_phase(const Frame& F, const float* src, unsigned char* dst, float* scl, int rows) {
    const int lane = F.lane, st = F.NGW;
    int r = F.gw; if (r >= rows) return;
    f32x4 a[8], b[8], c[8];
    row_load_nt(src + (size_t)r * DM, lane, a);
    if (r + st < rows) row_load_nt(src + (size_t)(r + st) * DM, lane, b);
    for (;;) {
        if (r + 2 * st < rows) row_load_nt(src + (size_t)(r + 2 * st) * DM, lane, c);
        tab_fp4_row(a, dst, scl, r, lane); r += st; if (r >= rows) break;
        if (r + 2 * st < rows) row_load_nt(src + (size_t)(r + 2 * st) * DM, lane, a);
        tab_fp4_row(b, dst, scl, r, lane); r += st; if (r >= rows) break;
        if (r + 2 * st < rows) row_load_nt(src + (size_t)(r + 2 * st) * DM, lane, b);
        tab_fp4_row(c, dst, scl, r, lane); r += st; if (r >= rows) break;
    }
}
constexpr int EB = 4;
struct EBatch { v4u ur[EB], vr[EB]; float gg[EB], su[EB]; };
__device__ __forceinline__ void ebatch_load(EBatch& B, int e0, int e_lo, int e_hi, float g_lo, float g_hi, float s_lo, float s_hi, const unsigned char* U4, const unsigned char* V4, int lane, const int emask) {
#pragma unroll
    for (int q = 0; q < EB; ++q) { const int e = e0 + q; const int ei = __builtin_amdgcn_readlane(e < 64 ? e_lo : e_hi, e & 63) & emask;
        B.gg[q] = __builtin_bit_cast(float, __builtin_amdgcn_readlane(__builtin_bit_cast(int, e < 64 ? g_lo : g_hi), e & 63));
        B.su[q] = __builtin_bit_cast(float, __builtin_amdgcn_readlane(__builtin_bit_cast(int, e < 64 ? s_lo : s_hi), e & 63));
        B.ur[q] = *(const v4u*)(U4 + (size_t)ei * TROW + 16 * lane); B.vr[q] = *(const v4u*)(V4 + (size_t)ei * TROW + 16 * lane); }
}
__device__ __forceinline__ float gelu_as(float v) {
    const float av = fabsf(v), t = __builtin_amdgcn_rcpf(av * 0.2316418882f + 1.0f);
    float q = t * 0.5307027145f + (-0.7265760135f); q = q * t + 0.7107068705f; q = q * t + (-0.142248368f); q = q * t + 0.127414796f; q = q * t;
    const float e = __builtin_amdgcn_exp2f((v * v) * (-0.72134752044f));
    const float m = v * (q * e);
    return v < 0.f ? m : v - m;
}
__device__ __forceinline__ void ebatch_compute(const EBatch& B, const f2v (&xf)[16], f2v (&acc)[16]) {
#pragma unroll
    for (int q = 0; q < EB; ++q) { f2v d2 = {0.f, 0.f};
#pragma unroll
        for (int j = 0; j < 4; ++j) {
            d2 += __builtin_amdgcn_cvt_scalef32_pk_f32_fp4(B.ur[q][j], 1.0f, 0) * xf[4 * j]; d2 += __builtin_amdgcn_cvt_scalef32_pk_f32_fp4(B.ur[q][j], 1.0f, 1) * xf[4 * j + 1];
            d2 += __builtin_amdgcn_cvt_scalef32_pk_f32_fp4(B.ur[q][j], 1.0f, 2) * xf[4 * j + 2]; d2 += __builtin_amdgcn_cvt_scalef32_pk_f32_fp4(B.ur[q][j], 1.0f, 3) * xf[4 * j + 3]; }
        const float d = wave_sum(d2.x + d2.y) * B.su[q];
        const float a = B.gg[q] * gelu_as(d); const f2v a2 = {a, a};
#pragma unroll
        for (int j = 0; j < 4; ++j) {
            acc[4 * j] += a2 * __builtin_amdgcn_cvt_scalef32_pk_f32_fp4(B.vr[q][j], 1.0f, 0); acc[4 * j + 1] += a2 * __builtin_amdgcn_cvt_scalef32_pk_f32_fp4(B.vr[q][j], 1.0f, 1);
            acc[4 * j + 2] += a2 * __builtin_amdgcn_cvt_scalef32_pk_f32_fp4(B.vr[q][j], 1.0f, 2); acc[4 * j + 3] += a2 * __builtin_amdgcn_cvt_scalef32_pk_f32_fp4(B.vr[q][j], 1.0f, 3); } }
}
__device__ __forceinline__ void expert4_phase(const Frame& F, float* H, const bf16* XN, unsigned char* XN8, const unsigned char* U4, const unsigned char* V4, const int* EIDX, const float* GATE, const float* SU, const float* SV, const float* nw, const unsigned long long* SS, const bool dry) {
    const int lane = F.lane;
    const int emask = dry ? DBG_EMASK : 0xFFFFFF;
    int t = F.gw; if (t >= SEQ) return;
    int e_lo = EIDX[(size_t)t * 128 + lane], e_hi = EIDX[(size_t)t * 128 + 64 + lane];
    float g_lo = GATE[(size_t)t * 128 + lane] * SV[e_lo], g_hi = GATE[(size_t)t * 128 + 64 + lane] * SV[e_hi], s_lo = SU[e_lo] * ss_rstd(SS[t]), s_hi = SU[e_hi] * ss_rstd(SS[t]);
    EBatch A, B;
    ebatch_load(A, 0, e_lo, e_hi, g_lo, g_hi, s_lo, s_hi, U4, V4, lane, emask);
    v4u xnn[4];
#pragma unroll
    for (int j = 0; j < 4; ++j) xnn[j] = *(const v4u*)(XN + (size_t)t * DM + lane * 8 + 512 * j);
    for (;;) {
        const int tn = t + F.NGW; const bool more = tn < SEQ; const int tq = more ? tn : t;
        f2v xf[16];
#pragma unroll
        for (int j = 0; j < 4; ++j) { const v4u a = xnn[j];
            xf[4 * j] = (f2v){bflo(a.x), bfhi(a.x)}; xf[4 * j + 1] = (f2v){bflo(a.y), bfhi(a.y)}; xf[4 * j + 2] = (f2v){bflo(a.z), bfhi(a.z)}; xf[4 * j + 3] = (f2v){bflo(a.w), bfhi(a.w)}; }
        const int ne_lo = EIDX[(size_t)tq * 128 + lane], ne_hi = EIDX[(size_t)tq * 128 + 64 + lane];
        const float ng_lo = GATE[(size_t)tq * 128 + lane] * SV[ne_lo], ng_hi = GATE[(size_t)tq * 128 + 64 + lane] * SV[ne_hi], ns_lo = SU[ne_lo] * ss_rstd(SS[tq]), ns_hi = SU[ne_hi] * ss_rstd(SS[tq]);
        f2v acc[16];
#pragma unroll
        for (int i = 0; i < 16; ++i) acc[i] = (f2v){0.f, 0.f};
        f32x4 hv[8];
        for (int e0 = 0; e0 < 128; e0 += 2 * EB) {
            if (e0 == 128 - 2 * EB) { row_load(H + (size_t)t * DM, lane, hv);
#pragma unroll
                for (int j = 0; j < 4; ++j) xnn[j] = *(const v4u*)(XN + (size_t)tq * DM + lane * 8 + 512 * j); }
            ebatch_load(B, e0 + EB, e_lo, e_hi, g_lo, g_hi, s_lo, s_hi, U4, V4, lane, emask);
#if DBG_LIGHT
            if (dry) {
#pragma unroll
                for (int q = 0; q < EB; ++q) { acc[0].x += __uint_as_float(A.ur[q].x ^ A.vr[q].y); acc[1].x += __uint_as_float(B.ur[q].z ^ B.vr[q].w); }
                if (e0 + 2 * EB < 128) ebatch_load(A, e0 + 2 * EB, e_lo, e_hi, g_lo, g_hi, s_lo, s_hi, U4, V4, lane, emask);
                else ebatch_load(A, 0, ne_lo, ne_hi, ng_lo, ng_hi, ns_lo, ns_hi, U4, V4, lane, emask);
                continue; }
#endif
            ebatch_compute(A, xf, acc);
            if (e0 + 2 * EB < 128) ebatch_load(A, e0 + 2 * EB, e_lo, e_hi, g_lo, g_hi, s_lo, s_hi, U4, V4, lane, emask);
            else ebatch_load(A, 0, ne_lo, ne_hi, ng_lo, ng_hi, ns_lo, ns_hi, U4, V4, lane, emask);
            ebatch_compute(B, xf, acc);
        }
#pragma unroll
        for (int j = 0; j < 8; ++j) { hv[j][0] += acc[2 * j].x; hv[j][1] += acc[2 * j].y; hv[j][2] += acc[2 * j + 1].x; hv[j][3] += acc[2 * j + 1].y; }
#pragma unroll
        for (int j = 0; j < 4; ++j) { if (!dry) { *(f32x4*)(H + (size_t)t * DM + lane * 8 + 512 * j) = hv[2 * j]; *(f32x4*)(H + (size_t)t * DM + lane * 8 + 512 * j + 4) = hv[2 * j + 1]; } }
        const float rstd = row_rstd(hv);
        if (!dry) row_store_norm8(hv, rstd, nw, XN8 + (size_t)t * DM, lane);
        if (!more) break;
        t = tn; e_lo = ne_lo; e_hi = ne_hi; g_lo = ng_lo; g_hi = ng_hi; s_lo = ns_lo; s_hi = ns_hi;
    }
}
}
#define XB_TMO      128
#define XB_XCNT(j)  (256  + 64 * (j))
#define XB_XSUB(j)  (1280 + 64 * (j))
#define XB_XGEN(j)  (2304 + 64 * (j))
#define XB_TOP      3328
#define XB_TOPGEN   3392
#define XCD_BAR_WORDS 3456
#define XB_SPIN_CAP (1u << 22)
__device__ __forceinline__ unsigned xb_ld(unsigned* p)              { return __hip_atomic_load(p, __ATOMIC_RELAXED, __HIP_MEMORY_SCOPE_AGENT); }
__device__ __forceinline__ unsigned xb_add(unsigned* p, unsigned v) { return __hip_atomic_fetch_add(p, v, __ATOMIC_RELAXED, __HIP_MEMORY_SCOPE_AGENT); }
__device__ __forceinline__ unsigned xb_xcc_id() { return (unsigned)__builtin_amdgcn_s_getreg((3 << 11) | 20) & 0xFu; }
#define XB_SPIN(cond, bar) do { unsigned _sp = 0; while (cond) { __builtin_amdgcn_s_sleep(1); \
    if ((++_sp & 255u) == 0u) { if (xb_ld(&(bar)[XB_TMO])) break; if (_sp > XB_SPIN_CAP) { atomicAdd(&(bar)[XB_TMO], 1u); break; } } } } while (0)
struct XcdBarrier { unsigned* bar; unsigned x; volatile LAS unsigned* st; };
__device__ __forceinline__ XcdBarrier xcd_barrier_post(unsigned* bar, volatile LAS unsigned* st, const int tid) {
    XcdBarrier b; b.bar = bar; b.x = xb_xcc_id(); b.st = st;
    if (tid == 0) (void)xb_add(&bar[XB_XCNT(b.x)], 1u);
    return b;
}
__device__ __forceinline__ void xcd_barrier_complete(unsigned* bar, unsigned x, unsigned& nloc, unsigned& nx) {
    const unsigned G = gridDim.x * gridDim.y * gridDim.z;
    unsigned sum, cnt, mine, sp = 0u;
    for (;;) {
        sum = 0u; cnt = 0u; mine = 0u;
#pragma unroll
        for (unsigned j = 0; j < 16; ++j) { const unsigned c = xb_ld(&bar[XB_XCNT(j)]); sum += c; cnt += (c > 0u) ? 1u : 0u; mine = (j == x) ? c : mine; }
        if (sum == G) break;
        __builtin_amdgcn_s_sleep(1);
        if ((++sp & 255u) == 0u) { if (xb_ld(&bar[XB_TMO])) break; if (sp > XB_SPIN_CAP) { atomicAdd(&bar[XB_TMO], 1u); break; } }
    }
    nloc = mine > 0u ? mine : 1u; nx = cnt > 0u ? cnt : 1u;
}
__device__ __forceinline__ void xcd_barrier(const XcdBarrier& b, const int tid) {
    asm volatile("s_waitcnt vmcnt(0)" ::: "memory");
    __syncthreads();
    if (tid == 0) {
        unsigned* bar = b.bar;
        __builtin_amdgcn_s_waitcnt(0);
        unsigned nloc = b.st[0], nx = b.st[1];
        if (nloc == 0u) { xcd_barrier_complete(bar, b.x, nloc, nx); b.st[0] = nloc; b.st[1] = nx; }
        const unsigned old = xb_add(&bar[XB_XSUB(b.x)], 1u);
        const unsigned gen = old / nloc;
        if (old + 1u == (gen + 1u) * nloc) {
            __builtin_amdgcn_fence(__ATOMIC_RELEASE, "agent");
            asm volatile("s_waitcnt vmcnt(0)" ::: "memory");
            const unsigned og = xb_add(&bar[XB_TOP], 1u);
            const unsigned tg = og / nx;
            if (og + 1u == (tg + 1u) * nx) xb_add(&bar[XB_TOPGEN], 1u);
            else XB_SPIN(xb_ld(&bar[XB_TOPGEN]) == tg, bar);
            __builtin_amdgcn_fence(__ATOMIC_ACQUIRE, "agent");
            xb_add(&bar[XB_XGEN(b.x)], 1u);
            asm volatile("s_waitcnt vmcnt(0)" ::: "memory");
        } else {
            XB_SPIN(xb_ld(&bar[XB_XGEN(b.x)]) == gen, bar);
            __builtin_amdgcn_fence(__ATOMIC_ACQUIRE, "agent");
            asm volatile("s_waitcnt vmcnt(0)" ::: "memory");
        }
    }
    __syncthreads();
}

constexpr int NWAVES = 8;
constexpr int RING_BYTES = 131072, LDSCTL_OFF = RING_BYTES, MISC_OFF = LDSCTL_OFF + 320, LDS_BYTES = 147456;
constexpr int NPH = 25;
struct Args { const float* in[27]; float* out; unsigned char* ws; int ph_lo, ph_hi, dry, pad; };

__device__ __forceinline__ fox::BlockRef fox_ref(int L, int pass, const bf16* Q, const bf16* K, const bf16* V, bf16* O) {
    const int hd = L >> 4, x = L & 15, qb = pass ? 31 - x : x;
    fox::BlockRef r; r.Q = Q + (size_t)qb * fox::QB * fox::RS + hd * fox::D; r.O = O + (size_t)qb * fox::QB * fox::RS + hd * fox::D;
    r.K = K + hd * fox::D; r.V = V + hd * fox::D; r.P0 = qb * fox::QB; return r;
}

__device__ __forceinline__ void run_gemm_fin(const Frame& F, const bf16* A, const bf16* Bt, int N, int K, const pg8::EpiFin& E) {
    LAS unsigned char* lds = F.lds; const int G = F.G;
    asm volatile("" : "+s"(K), "+s"(N));
    pg8::Gemm g{A, Bt, SEQ, N, K}; pg8::StaticOrder S; S.init(SEQ, N, G, F.bx);
    pg8::gemm_phase<pg8::EpiFin, pg8::StaticOrder, true, true, true>(lds, g, S, E, F.tid);
}
template <int MODE, bool FP8 = false>
__device__ __forceinline__ void run_gemm(const Frame& F, const bf16* A, const bf16* Bt, int N, int K, const pg8::EpiG<MODE>& E) {
    LAS unsigned char* lds = F.lds; const int G = F.G;
    asm volatile("" : "+s"(K), "+s"(N));
    pg8::Gemm g{A, Bt, SEQ, N, K}; pg8::StaticOrder S; S.init(SEQ, N, G, F.bx);
    pg8::gemm_phase<pg8::EpiG<MODE>, pg8::StaticOrder, true, true, FP8>(lds, g, S, E, F.tid);
}

__device__ __forceinline__ int lane_id_() { unsigned m = ~0u; asm volatile("" : "+s"(m)); return (int)__builtin_amdgcn_mbcnt_hi(m, __builtin_amdgcn_mbcnt_lo(m, 0u)); }
__device__ __forceinline__ Frame mkframe(unsigned char* lds_raw, int wave_s) {
    Frame F; F.lds = (LAS unsigned char*)lds_raw;
    int bx_ = blockIdx.x; asm volatile("" : "+s"(bx_), "+s"(wave_s));
    F.wave = wave_s; F.lane = lane_id_(); F.tid = wave_s * 64 + F.lane; F.bx = bx_;
    F.G = gridDim.x; { const int bx = bx_; F.vcu = (F.G % 8 == 0) ? (bx % 8) * (F.G / 8) + bx / 8 : bx; }
    F.gw = F.vcu * NWAVES + F.wave; F.NGW = F.G * NWAVES; F.gt = F.vcu * (NWAVES * 64) + F.tid; F.NGT = F.G * NWAVES * 64;
    return F;
}
#define PHASE_BEGIN const __attribute__((address_space(4))) Args* ap = (const __attribute__((address_space(4))) Args*)__builtin_amdgcn_kernarg_segment_ptr(); asm volatile("" : "+s"(ap)); unsigned char* const ws = ap->ws; const Frame F = mkframe(lds_raw, wave_s); (void)ws; (void)F
#define INP(k) (ap->in[k])
#define WSP(T, off) ((T*)(ws + (off)))
constexpr size_t TABN = (size_t)NEXP * DM;

__global__ void __launch_bounds__(NWAVES * 64, 2) yoco_fwd(Args args) {
    extern __shared__ __attribute__((aligned(16))) unsigned char lds_raw[];
    const int wave_s = __builtin_amdgcn_readfirstlane((int)threadIdx.x >> 6);
    { LAS unsigned* z = (LAS unsigned*)((LAS unsigned char*)lds_raw + LDSCTL_OFF); for (int u = wave_s * 64 + lane_id_(); u < (LDS_BYTES - LDSCTL_OFF) / 4; u += NWAVES * 64) z[u] = 0u; }
    __syncthreads();
    const int lo = args.ph_lo, hi = args.ph_hi;
    XcdBarrier bar; bar.bar = (unsigned*)(args.ws + WS_CTL) + CW_BAR; bar.x = 0; bar.st = (volatile LAS unsigned*)((LAS unsigned char*)lds_raw + MISC_OFF) + 8;
    if (hi - lo > 1) bar = xcd_barrier_post(bar.bar, bar.st, wave_s * 64 + lane_id_());
#ifdef ONLY_PH
#define IN(k) ((k) == ONLY_PH)
#elif defined(PHMASK)
#define IN(k) (((PHMASK >> (k)) & 1) && lo <= (k) && (k) < hi)
#else
#define IN(k) (lo <= (k) && (k) < hi)
#endif
#define PH(k) if (IN(k))
#define RBAR(k) const bool dry = ap->dry != 0; (void)dry
#define SEAM(k) do { if (IN(k) && IN((k) + 1)) xcd_barrier(bar, wave_s * 64 + lane_id_()); } while (0)

    PH(0) { PHASE_BEGIN; RBAR(0);
        LAS float* scr = (LAS float*)(F.lds + F.wave * 16384);
        constexpr int I_IN = 32 * 322, I_OUT = 64 * 64, I_KV = 32 * 128, I_SQ = 32 * 64, I_EP = 4 * 64;
        constexpr int NITEMS = I_IN + I_OUT + I_KV + 6 * I_SQ + 2 * I_EP;
        auto decode = [&](int r) -> P0Item {
            if (r < I_IN) return P0Item{INP(3), (unsigned char*)WSP(bf16, WS_WIN), 2048, DINP, DINP, r, 0}; r -= I_IN;
            if (r < I_OUT) return P0Item{INP(10), (unsigned char*)WSP(bf16, WS_WOUT), 4096, 2048, 2048, r, 0}; r -= I_OUT;
            if (r < I_KV) return P0Item{INP(12), WSP(unsigned char, WS_WKV), 2048, 4096, 4112, r, 1}; r -= I_KV;
            if (r < I_SQ) return P0Item{INP(15), WSP(unsigned char, WS_WQ), 2048, 2048, 2048, r, 1}; r -= I_SQ;
            if (r < I_SQ) return P0Item{INP(16), (unsigned char*)WSP(bf16, WS_WO), 2048, 2048, 2048, r, 0}; r -= I_SQ;
            if (r < 2 * I_SQ) { const int l = r / I_SQ; return P0Item{INP(18) + (size_t)l * 2048 * 2048, (unsigned char*)(WSP(bf16, WS_WCQ) + (size_t)l * 2048 * 2048), 2048, 2048, 2048, r % I_SQ, 0}; } r -= 2 * I_SQ;
            if (r < 2 * I_SQ) { const int l = r / I_SQ; return P0Item{INP(23) + (size_t)l * 2048 * 2048, WSP(unsigned char, WS_WEG) + (size_t)l * 2048 * 2048, 2048, 2048, 2048, r % I_SQ, 1}; } r -= 2 * I_SQ;
            { const int l = r / I_EP; return P0Item{INP(25) + (size_t)l * 256 * 2048, (unsigned char*)(WSP(bf16, WS_WEP) + (size_t)l * 2048 * 256), 256, 2048, 2048, r % I_EP, 0}; }
        };
        { int it = F.gw;
          if (it < NITEMS) {
            float ta[32], tb[32]; P0Item I0 = decode(it), I1 = I0;
            p0_load(I0, F.lane, ta);
            for (;;) {
                const int i1 = it + F.NGW; const bool h1 = i1 < NITEMS;
                if (h1) { I1 = decode(i1); p0_load(I1, F.lane, tb); }
                p0_emit(I0, F.lane, ta, scr);
                if (!h1) break;
                const int i2 = i1 + F.NGW; const bool h2 = i2 < NITEMS;
                if (h2) { I0 = decode(i2); p0_load(I0, F.lane, ta); }
                p0_emit(I1, F.lane, tb, scr);
                if (!h2) break;
                it = i2;
            } } }
        cvt_f32_bf16(F, INP(19), WSP(bf16, WS_SK), (size_t)2 * PH * 2 * NKEY * 128 / 8);
        cvt_f32_bf16(F, INP(1), WSP(bf16, WS_PBF), (size_t)2 * SEQ * PLE / 8);
        norm_phase<true>(F, INP(0), INP(2), WSP(bf16, WS_XN));
    }
    SEAM(0);
    PH(1) { PHASE_BEGIN; RBAR(1);
        { pg8::EpiG<pg8::EP_INPROJ> E{WSP(bf16, WS_Z), WSP(bf16, WS_XBC), WSP(float, WS_DT), nullptr, nullptr, 0}; run_gemm<pg8::EP_INPROJ>(F, WSP(bf16, WS_XN), WSP(bf16, WS_WIN), 10240, 2048, E); }
    }
    PH(1) { PHASE_BEGIN; RBAR(1);
#pragma unroll 1
        for (int l = 0; l < 2; ++l) { pg8::EpiG<pg8::EP_BF16> E{WSP(bf16, WS_PP) + (size_t)l * SEQ * DM, nullptr, nullptr, nullptr, nullptr, DM}; run_gemm<pg8::EP_BF16>(F, WSP(bf16, WS_PBF) + (size_t)l * SEQ * PLE, WSP(bf16, WS_WEP) + (size_t)l * 2048 * 256, DM, PLE, E); }
        for (int u = F.vcu; u < SEQ / 32; u += F.G) dt_unit(F.lds, u, WSP(bf16, WS_XN), WSP(bf16, WS_WIN) + (size_t)10240 * 2048, WSP(float, WS_DT), F.tid);
    }
    SEAM(1);
    PH(2) { PHASE_BEGIN; RBAR(2);
        if (!dry) for (int c = F.bx; c < NCH; c += F.G) acum_unit(F, c, WSP(float, WS_DT), INP(6), INP(7), WSP(float, WS_ACL));
        conv_phase(F, WSP(bf16, WS_XBC), INP(4), INP(5), WSP(bf16, WS_XBCC));
    }
    SEAM(2);
    PH(3) { PHASE_BEGIN; RBAR(3); for (int u = F.vcu; u < NCH * NG; u += F.G) ssd::s1_unit(F.lds, u >> 3, u & 7, WSP(bf16, WS_XBCC), WSP(float, WS_DT), WSP(float, WS_ACL), WSP(float, WS_SLOC), F.tid); }
    SEAM(3);
    PH(4) { PHASE_BEGIN; RBAR(4); ssd::s2_phase(F, WSP(float, WS_SLOC), WSP(float, WS_ACL), WSP(bf16, WS_SIN)); }
    SEAM(4);
    PH(5) { PHASE_BEGIN; RBAR(5); for (int u = F.vcu; u < NCH * NG; u += F.G) ssd::s3p_unit(F.lds, u >> 3, u & 7, WSP(bf16, WS_XBCC), WSP(float, WS_DT), WSP(float, WS_ACL), WSP(bf16, WS_SIN), INP(8), WSP(bf16, WS_Y), F.tid, dry ? DBG_S3MODE : 0); }
    SEAM(5);
    PH(6) { PHASE_BEGIN; RBAR(6);
        gnorm_phase(F, WSP(bf16, WS_Y), WSP(bf16, WS_Z), INP(9), dry);
    }
    SEAM(6);
    PH(7) { PHASE_BEGIN; RBAR(7); pg8::EpiG<pg8::EP_RESX> E{WSP(bf16, WS_XN), nullptr, WSP(float, WS_H), INP(0), nullptr, (DBG_SKIP & 1), INP(17), (unsigned long long*)((unsigned*)(ws + WS_CTL) + CW_ROWSS)}; run_gemm<pg8::EP_RESX>(F, WSP(bf16, WS_Y), WSP(bf16, WS_WOUT), DM, DI, E); }
    SEAM(7);
    { constexpr int l = 0, pb = 8;
        PH(pb + 1) { PHASE_BEGIN; RBAR(pb + 1); pg8::EpiG<pg8::EP_BF16S> E{WSP(bf16, WS_PQ), nullptr, nullptr, nullptr, nullptr, DM, nullptr, (unsigned long long*)((unsigned*)(ws + WS_CTL) + CW_ROWSS) + l * SEQ}; run_gemm<pg8::EP_BF16S>(F, WSP(bf16, WS_XN), WSP(bf16, WS_WCQ) + (size_t)l * 2048 * 2048, DM, DM, E); }
        SEAM(pb + 1);
        PH(pb + 2) { PHASE_BEGIN; RBAR(pb + 2);
#pragma unroll 1
            for (int step = 0; step < 2; ++step) {
                const Frame Fs = mkframe(lds_raw, wave_s);
                if ((step == 0) == ((wave_s & 1) != 0)) { for (int u = Fs.gw; u < (SEQ / 32) * PH; u += Fs.NGW) peer::topk2_unit(Fs.lds + Fs.wave * 1024, u & 255, u >> 8, WSP(bf16, WS_PQ), WSP(bf16, WS_SK) + (size_t)l * PH * 2 * NKEY * 128, WSP(int, WS_EIDX), WSP(float, WS_GATE)); }
                else { if (l == 0) peer::tab_fp4_phase(Fs, INP(20) + (size_t)l * TABN, WSP(unsigned char, WS_TAB) + (size_t)l * TABN, WSP(float, WS_TSC) + l * NEXP, NEXP);
                       peer::tab_fp4_phase(Fs, INP(21) + (size_t)l * TABN, WSP(unsigned char, WS_TAB) + (size_t)l * TABN + 1024, WSP(float, WS_TSC) + (2 + l) * NEXP, NEXP); } } }
        SEAM(pb + 2);
        PH(pb + 3) { PHASE_BEGIN; RBAR(pb + 3); peer::expert4_phase(F, WSP(float, WS_H), WSP(bf16, WS_XN), WSP(unsigned char, WS_XN2), WSP(unsigned char, WS_TAB) + (size_t)l * TABN, WSP(unsigned char, WS_TAB) + (size_t)l * TABN + 1024, WSP(int, WS_EIDX), WSP(float, WS_GATE), WSP(float, WS_TSC) + l * NEXP, WSP(float, WS_TSC) + (2 + l) * NEXP, INP(22) + l * DM, (const unsigned long long*)((const unsigned*)(ws + WS_CTL) + CW_ROWSS) + l * SEQ, dry); }
        SEAM(pb + 3);
        PH(pb + 4) { PHASE_BEGIN; RBAR(pb + 4); pg8::EpiG<pg8::EP_PLE> E{nullptr, nullptr, WSP(float, WS_H), INP(24) + l * DM, WSP(bf16, WS_PP) + (size_t)l * SEQ * DM, (DBG_SKIP & (l ? 32 : 4)) | (int)dry}; run_gemm<pg8::EP_PLE, true>(F, (const bf16*)WSP(unsigned char, WS_XN2), (const bf16*)(WSP(unsigned char, WS_WEG) + (size_t)l * 2048 * 2048), DM, DM, E); }
        SEAM(pb + 4);
    }
        PH(13) { PHASE_BEGIN; RBAR(13);
            kvnorm_stage(F, INP(12));
#pragma unroll 1
            for (int step = 0; step < 2; ++step) {
                const Frame Fs = mkframe(lds_raw, wave_s);
                if ((step == 0) == ((wave_s & 1) != 0)) { if (!dry) peer::tab_fp4_phase(Fs, INP(20) + TABN, WSP(unsigned char, WS_TAB) + TABN, WSP(float, WS_TSC) + NEXP, NEXP); }
                else kvnorm_rows(Fs, WSP(float, WS_H), INP(11), INP(14), INP(13), WSP(unsigned char, WS_XN), WSP(unsigned char, WS_XN2), WSP(float, WS_LOGF)); }
            __syncthreads(); }
        SEAM(13);
        PH(14) { PHASE_BEGIN; RBAR(14);
            for (int f = F.bx; f < FH; f += F.G) cumsum_unit(F, f, WSP(float, WS_LOGF), WSP(float, WS_NB));
            { pg8::EpiG<pg8::EP_KV> E{WSP(bf16, WS_K), WSP(bf16, WS_V), nullptr, nullptr, nullptr, 0}; run_gemm<pg8::EP_KV, true>(F, (const bf16*)WSP(unsigned char, WS_XN), (const bf16*)WSP(unsigned char, WS_WKV), 4096, DM, E); }
        }
        PH(14) { PHASE_BEGIN; RBAR(14);
            { pg8::EpiG<pg8::EP_BF16> E{WSP(bf16, WS_Q), nullptr, nullptr, nullptr, nullptr, DM}; run_gemm<pg8::EP_BF16, true>(F, (const bf16*)WSP(unsigned char, WS_XN2), (const bf16*)WSP(unsigned char, WS_WQ), DM, DM, E); }
        }
        SEAM(14);
        PH(15) { PHASE_BEGIN; RBAR(15); qknorm_phase(F, WSP(bf16, WS_Q), WSP(bf16, WS_K), (unsigned*)(ws + WS_CTL) + CW_NORM); }
        SEAM(15);
        PH(16) { PHASE_BEGIN; RBAR(16);
            fox::ItemQ iq; iq.tick = (unsigned*)(ws + WS_CTL) + CW_TICKET + (dry ? 1024 : 0); iq.bc = (volatile LAS unsigned*)(F.lds + MISC_OFF) + 16; iq.NB = WSP(float, WS_NB);
            iq.NORM = (const unsigned*)(ws + WS_CTL) + CW_NORM; iq.Q = WSP(bf16, WS_Q); iq.K = WSP(bf16, WS_K); iq.V = WSP(bf16, WS_V); iq.O = WSP(bf16, WS_O); iq.OP = WSP(bf16, WS_OP); iq.ML = WSP(float, WS_ML); iq.xq = F.vcu >> 5;
#define FOX_NBLOAD(it) do { LAS f32x4* nbl_ = (LAS f32x4*)(F.lds + fox::LDS_BYTES); const f32x4* src_ = (const f32x4*)(iq.NB + (size_t)fox::item_head(it) * SEQ); \
                unsigned i0_ = (unsigned)(wave_s * 64 + lane_id_()); asm volatile("" : "+v"(i0_)); \
                _Pragma("unroll") for (unsigned k_ = 0; k_ < SEQ / 4 / (NWAVES * 64); ++k_) nbl_[i0_ + k_ * NWAVES * 64] = src_[i0_ + k_ * NWAVES * 64]; } while (0)
            int it = fox::q_pull(iq, F.tid);
            if (it < fox::NITEM) {
                fox::Seam S; fox::BlockRef cur = fox::q_ref(iq, it, F.lane), nxt;
                FOX_NBLOAD(it);
                fox::causal_prime(cur, (char*)lds_raw, S, wave_s * 64 + lane_id_());
                for (;;) {
                    int itn;
                    fox::causal_block(cur, nxt, itn, iq, SEQ, (char*)lds_raw, S, wave_s * 64 + lane_id_());
                    if (itn >= fox::NITEM) break;
                    if (fox::item_head(itn) != fox::item_head(it)) { FOX_NBLOAD(itn); __syncthreads(); }
                    cur = nxt; it = itn;
                }
            }
#undef FOX_NBLOAD
        }
        SEAM(16);
        PH(17) { PHASE_BEGIN; RBAR(17); attn_combine_phase(F, WSP(bf16, WS_O), WSP(bf16, WS_OP), WSP(float, WS_ML)); }
        SEAM(17);
        PH(18) { PHASE_BEGIN; RBAR(18); pg8::EpiG<pg8::EP_RESH> E{WSP(bf16, WS_XN), nullptr, WSP(float, WS_H), nullptr, nullptr, (int)dry, INP(17) + DM, (unsigned long long*)((unsigned*)(ws + WS_CTL) + CW_ROWSS) + SEQ}; run_gemm<pg8::EP_RESH>(F, WSP(bf16, WS_O), WSP(bf16, WS_WO), DM, DM, E); }
        SEAM(18);
    { constexpr int l = 1, pb = 19;
        PH(pb + 1) { PHASE_BEGIN; RBAR(pb + 1); pg8::EpiG<pg8::EP_BF16S> E{WSP(bf16, WS_PQ), nullptr, nullptr, nullptr, nullptr, DM, nullptr, (unsigned long long*)((unsigned*)(ws + WS_CTL) + CW_ROWSS) + l * SEQ}; run_gemm<pg8::EP_BF16S>(F, WSP(bf16, WS_XN), WSP(bf16, WS_WCQ) + (size_t)l * 2048 * 2048, DM, DM, E); }
        SEAM(pb + 1);
        PH(pb + 2) { PHASE_BEGIN; RBAR(pb + 2);
#pragma unroll 1
            for (int step = 0; step < 2; ++step) {
                const Frame Fs = mkframe(lds_raw, wave_s);
                if ((step == 0) == ((wave_s & 1) != 0)) { for (int u = Fs.gw; u < (SEQ / 32) * PH; u += Fs.NGW) peer::topk2_unit(Fs.lds + Fs.wave * 1024, u & 255, u >> 8, WSP(bf16, WS_PQ), WSP(bf16, WS_SK) + (size_t)l * PH * 2 * NKEY * 128, WSP(int, WS_EIDX), WSP(float, WS_GATE)); }
                else { if (l == 0) peer::tab_fp4_phase(Fs, INP(20) + (size_t)l * TABN, WSP(unsigned char, WS_TAB) + (size_t)l * TABN, WSP(float, WS_TSC) + l * NEXP, NEXP);
                       peer::tab_fp4_phase(Fs, INP(21) + (size_t)l * TABN, WSP(unsigned char, WS_TAB) + (size_t)l * TABN + 1024, WSP(float, WS_TSC) + (2 + l) * NEXP, NEXP); } } }
        SEAM(pb + 2);
        PH(pb + 3) { PHASE_BEGIN; RBAR(pb + 3); peer::expert4_phase(F, WSP(float, WS_H), WSP(bf16, WS_XN), WSP(unsigned char, WS_XN2), WSP(unsigned char, WS_TAB) + (size_t)l * TABN, WSP(unsigned char, WS_TAB) + (size_t)l * TABN + 1024, WSP(int, WS_EIDX), WSP(float, WS_GATE), WSP(float, WS_TSC) + l * NEXP, WSP(float, WS_TSC) + (2 + l) * NEXP, INP(22) + l * DM, (const unsigned long long*)((const unsigned*)(ws + WS_CTL) + CW_ROWSS) + l * SEQ, dry); }
        SEAM(pb + 3);
        if (gridDim.x == 256) {
            PH(pb + 4) { PHASE_BEGIN; RBAR(pb + 4); unsigned* cw = (unsigned*)(ws + WS_CTL);
                pg8::EpiFin E{WSP(float, WS_H), INP(24) + l * DM, WSP(bf16, WS_PP) + (size_t)l * SEQ * DM, INP(26), (unsigned long long*)(cw + CW_FINSS), cw + CW_FINCNT, ap->out, (int)dry};
                run_gemm_fin(F, (const bf16*)WSP(unsigned char, WS_XN2), (const bf16*)(WSP(unsigned char, WS_WEG) + (size_t)l * 2048 * 2048), DM, DM, E); }
        } else {
            PH(pb + 4) { PHASE_BEGIN; RBAR(pb + 4); pg8::EpiG<pg8::EP_PLE> E{nullptr, nullptr, WSP(float, WS_H), INP(24) + l * DM, WSP(bf16, WS_PP) + (size_t)l * SEQ * DM, (DBG_SKIP & (l ? 32 : 4)) | (int)dry}; run_gemm<pg8::EP_PLE, true>(F, (const bf16*)WSP(unsigned char, WS_XN2), (const bf16*)(WSP(unsigned char, WS_WEG) + (size_t)l * 2048 * 2048), DM, DM, E); }
            SEAM(pb + 4);
            PH(24) { PHASE_BEGIN; RBAR(24); final_norm_phase(F, WSP(float, WS_H), INP(26), ap->out); }
        }
    }
#undef IN
#undef SEAM
}

extern "C" void kernel_launch(void* const* d_in, const int* in_sizes, int n_in, void* d_out, int out_size, void* d_ws, size_t ws_size, hipStream_t stream) {
    static int grid = 0;
    if (grid == 0) {
        if (n_in != 27 || out_size != SEQ * DM || ws_size < WS_END) { fprintf(stderr, "kernel_launch: expected 27 inputs, out %d, ws >= %zu; got n_in %d out %d ws %zu\n", SEQ * DM, (size_t)WS_END, n_in, out_size, ws_size); grid = -1; return; }
        int dev = 0, cus = 0, per_cu = 0;
        if (hipGetDevice(&dev) != hipSuccess || hipDeviceGetAttribute(&cus, hipDeviceAttributeMultiprocessorCount, dev) != hipSuccess) { fprintf(stderr, "kernel_launch: device query failed\n"); grid = -1; return; }
        if (hipFuncSetAttribute((const void*)yoco_fwd, hipFuncAttributeMaxDynamicSharedMemorySize, LDS_BYTES) != hipSuccess) { fprintf(stderr, "kernel_launch: hipFuncSetAttribute failed\n"); grid = -1; return; }
        if (hipOccupancyMaxActiveBlocksPerMultiprocessor(&per_cu, (const void*)yoco_fwd, NWAVES * 64, LDS_BYTES) != hipSuccess || per_cu < 1) { fprintf(stderr, "kernel_launch: occupancy query says %d blocks/CU\n", per_cu); (void)hipGetLastError(); }
        grid = cus;
    }
    if (grid < 0) return;
    if (hipMemsetAsync((char*)d_ws + WS_CTL, 0, CTL_ZERO_BYTES, stream) != hipSuccess) { fprintf(stderr, "kernel_launch: memset failed\n"); return; }
    Args a{};
    for (int i = 0; i < 27; ++i) a.in[i] = (const float*)d_in[i];
    a.out = (float*)d_out; a.ws = (unsigned char*)d_ws;
#if MK_PER_PHASE
    for (int ph = 0; ph < NPH; ++ph) { a.ph_lo = ph; a.ph_hi = ph + 1;
        for (int rep = 0; rep < DBG_NREP; ++rep) if (ph == DBG_REPEAT) { a.dry = 1; hipLaunchKernelGGL(yoco_fwd, dim3(grid), dim3(NWAVES * 64), LDS_BYTES, stream, a); a.dry = 0; }
        hipLaunchKernelGGL(yoco_fwd, dim3(grid), dim3(NWAVES * 64), LDS_BYTES, stream, a); }
#else
    a.ph_lo = 0; a.ph_hi = NPH;
    void* kargs[] = {&a};
    hipError_t e = hipLaunchCooperativeKernel((const void*)yoco_fwd, dim3(grid), dim3(NWAVES * 64), kargs, LDS_BYTES, stream);
    if (e != hipSuccess) fprintf(stderr, "kernel_launch: cooperative launch failed: %s (grid %d)\n", hipGetErrorString(e), grid);
#endif
}
```

```cpp
#include <hip/hip_runtime.h>
#include <hip/hip_bf16.h>
#include <hip/hip_cooperative_groups.h>
#include <cstdio>
#include <cstdint>
#include <cmath>
namespace cg = cooperative_groups;

#ifndef DBG_SKIP
#define DBG_SKIP 0
#endif
#ifndef DBG_BRUTE
#define DBG_BRUTE 0
#endif
#ifndef DBG_F32TAB
#define DBG_F32TAB 0
#endif
#ifndef DBG_SCORES
#define DBG_SCORES 0
#endif
#ifndef DBG_LIGHT
#define DBG_LIGHT 0
#endif
#ifndef DBG_S3MODE
#define DBG_S3MODE 0
#endif
#ifndef DBG_EMASK
#define DBG_EMASK 0xFFFFFF
#endif
#ifndef DBG_NREP
#define DBG_NREP 1
#endif
#ifndef DBG_REPEAT
#define DBG_REPEAT (-1)
#endif
#ifndef MK_PER_PHASE
#define MK_PER_PHASE 0
#endif

constexpr int SEQ = 8192, DM = 2048, DI = 4096, NHS = 64, HP = 64, NG = 8, NST = 128, CONVD = 6144, DINP = 10304, DINP_PAD = 10496;
constexpr int CHK = 256, NCH = SEQ / CHK;
constexpr int FH = 16, FD = 128;
constexpr int PH = 8, NKEY = 128, TOPK = 16, NEXP = 16384, PLE = 256;
constexpr float RMS_EPS = 1e-6f, GN_EPS = 1e-5f;
constexpr float LOG2E = 1.4426950408889634f;

constexpr size_t MiB = 1u << 20;
constexpr size_t WS_CTL = 0, CTL_ZERO_BYTES = 1 * MiB;
constexpr size_t WS_WIN = 1 * MiB;
constexpr size_t WS_WOUT = 42 * MiB;
constexpr size_t WS_WKV = 58 * MiB;
constexpr size_t WS_WQ = 74 * MiB;
constexpr size_t WS_WO = 82 * MiB;
constexpr size_t WS_WCQ = 90 * MiB;
constexpr size_t WS_WEG = 106 * MiB;
constexpr size_t WS_WEP = 122 * MiB;
constexpr size_t WS_SK = 124 * MiB;
constexpr size_t WS_PBF = 125 * MiB;
constexpr size_t WS_PP = 133 * MiB;
constexpr size_t WS_H = 197 * MiB;
constexpr size_t WS_XN = 261 * MiB;
constexpr size_t WS_SMALL = 293 * MiB;
constexpr size_t WS_DT = WS_SMALL, WS_ACL = WS_SMALL + 2 * MiB, WS_LOGF = WS_SMALL + 4 * MiB, WS_NB = WS_SMALL + 5 * MiB;
constexpr size_t WS_WFP = WS_SMALL + 6 * MiB;
constexpr size_t WS_OV = 300 * MiB;
constexpr size_t WS_Z = WS_OV;
constexpr size_t WS_XBC = WS_OV + 64 * MiB;
constexpr size_t WS_Y = WS_XBC;
constexpr size_t WS_XBCC = WS_OV + 160 * MiB;
constexpr size_t WS_SLOC = WS_OV + 256 * MiB;
constexpr size_t WS_SIN = WS_OV + 320 * MiB;
constexpr size_t WS_Q = WS_OV, WS_K = WS_OV + 32 * MiB, WS_V = WS_OV + 64 * MiB, WS_O = WS_OV + 96 * MiB;
constexpr size_t WS_PQ = WS_OV + 128 * MiB;
constexpr size_t WS_TAB = WS_OV + 160 * MiB;
constexpr size_t WS_TSC = WS_OV + 288 * MiB;
constexpr size_t WS_XN2 = WS_OV + 416 * MiB;
constexpr size_t WS_EIDX = WS_OV + 448 * MiB;
constexpr size_t WS_GATE = WS_OV + 452 * MiB;
constexpr size_t WS_SUE = WS_OV + 456 * MiB;
constexpr size_t WS_OP = WS_OV + 460 * MiB;
constexpr size_t WS_ML = WS_OV + 524 * MiB;
constexpr size_t WS_END = WS_OV + 526 * MiB;

constexpr int CW_TMO = 0, CW_CODE = 1, CW_BAR = 4096, CW_NORM = 8192, CW_TICKET = 8320, CW_ROWSS = 32768, CW_FINSS = 65536, CW_FINCNT = 81920;
constexpr float SS_FIX = 4096.f;

#define GAS __attribute__((address_space(1)))
#define LAS __attribute__((address_space(3)))
typedef unsigned short bf16;
typedef unsigned v4u __attribute__((ext_vector_type(4)));
typedef unsigned v2u __attribute__((ext_vector_type(2)));
typedef float f32x4 __attribute__((ext_vector_type(4)));
typedef float f32x2_t __attribute__((ext_vector_type(2)));
typedef float f32x16 __attribute__((ext_vector_type(16)));
typedef short bf16x8 __attribute__((ext_vector_type(8)));
typedef short s16x4 __attribute__((ext_vector_type(4)));
typedef __bf16 bf16x2_t __attribute__((ext_vector_type(2)));
typedef GAS unsigned gu32;
#define RLX_AGENT __ATOMIC_RELAXED, __HIP_MEMORY_SCOPE_AGENT
#define LDS_WAIT() asm volatile("s_waitcnt lgkmcnt(0)" ::: "memory")
#define VM_WAIT() asm volatile("s_waitcnt vmcnt(0)" ::: "memory")
#define SBAR() __builtin_amdgcn_sched_barrier(0)

__device__ __forceinline__ unsigned cvtpk(float lo, float hi) { f32x2_t v = {lo, hi}; bf16x2_t b = __builtin_convertvector(v, bf16x2_t); return __builtin_bit_cast(unsigned, b); }
__device__ __forceinline__ float bflo(unsigned u) { return __builtin_bit_cast(float, u << 16); }
__device__ __forceinline__ float bfhi(unsigned u) { return __builtin_bit_cast(float, u & 0xffff0000u); }
#define DPP_F(v, ctrl) __builtin_bit_cast(float, __builtin_amdgcn_update_dpp(__builtin_bit_cast(int, v), __builtin_bit_cast(int, v), ctrl, 0xF, 0xF, false))
__device__ __forceinline__ float wave_sum(float v) {
    v += DPP_F(v, 0xB1); v += DPP_F(v, 0x4E); v += DPP_F(v, 0x141); v += DPP_F(v, 0x140);
    const float a = __builtin_bit_cast(float, __builtin_amdgcn_readlane(__builtin_bit_cast(int, v), 0)), b = __builtin_bit_cast(float, __builtin_amdgcn_readlane(__builtin_bit_cast(int, v), 16));
    const float c = __builtin_bit_cast(float, __builtin_amdgcn_readlane(__builtin_bit_cast(int, v), 32)), d = __builtin_bit_cast(float, __builtin_amdgcn_readlane(__builtin_bit_cast(int, v), 48));
    return (a + b) + (c + d);
}
__device__ __forceinline__ float wave_max(float v) {
    v = fmaxf(v, DPP_F(v, 0xB1)); v = fmaxf(v, DPP_F(v, 0x4E)); v = fmaxf(v, DPP_F(v, 0x141)); v = fmaxf(v, DPP_F(v, 0x140));
    const float a = __builtin_bit_cast(float, __builtin_amdgcn_readlane(__builtin_bit_cast(int, v), 0)), b = __builtin_bit_cast(float, __builtin_amdgcn_readlane(__builtin_bit_cast(int, v), 16));
    const float c = __builtin_bit_cast(float, __builtin_amdgcn_readlane(__builtin_bit_cast(int, v), 32)), d = __builtin_bit_cast(float, __builtin_amdgcn_readlane(__builtin_bit_cast(int, v), 48));
    return fmaxf(fmaxf(a, b), fmaxf(c, d));
}
__device__ __forceinline__ float ss_rstd(unsigned long long s) { return 1.f / sqrtf((float)s * (1.f / (SS_FIX * 2048.f)) + 1e-6f); }
__device__ __forceinline__ float sigmoidf_(float x) { return __builtin_amdgcn_rcpf(1.f + __expf(-x)); }
__device__ __forceinline__ float siluf_(float x) { return x * __builtin_amdgcn_rcpf(1.f + __expf(-x)); }
namespace pg8 {
#define PG8_LAS __attribute__((address_space(3)))
typedef unsigned short bf16_t;
typedef short bf16x8 __attribute__((ext_vector_type(8)));
typedef float f32x4 __attribute__((ext_vector_type(4)));
typedef unsigned u32x4 __attribute__((ext_vector_type(4)));
constexpr int BM = 256, BK = 64, HALF = 128, HTB = HALF * BK * 2  , STAGE_BYTES = 8 * HTB, NXCD = 8, WGM = 8;

__host__ __device__ __forceinline__ int lds_byte(int r, int c) { const int st = (r >> 4) * 2 + (c >> 5), rr = r & 15, cc = c & 31, ob = rr * 64 + cc * 2; return st * 1024 + (ob ^ (((ob >> 9) & 1) << 5)); }
__host__ __device__ __forceinline__ void stage_rc(int b, int& R, int& C) { const int st = b / 1024, sb = b % 1024, swz = sb ^ (((sb >> 9) & 1) << 5); R = (st >> 1) * 16 + swz / 64; C = (st & 1) * 32 + (swz % 64) / 2; }
__host__ __device__ __forceinline__ int perm32(int rho) { const int n = rho >> 4, i = rho & 15; return 8 * (i >> 2) + 4 * n + (i & 3); }

struct Unit { int pm, pn; };
struct Gemm { const bf16_t* A; const bf16_t* Bt; int M, N, K; };

struct StaticOrder {
    int nM, nN, nwg, G, c;
    __host__ __device__ void init(int M, int N, int G_, int c_) { nM = M / BM; nN = N / BM; nwg = nM * nN; G = G_; c = c_; }
    __host__ __device__ bool next(int i, Unit& u) const {
        const long L = (long)i * G + c; if (L >= nwg) return false;
        int wgid = (int)L; { const int q = nwg / NXCD, r = nwg % NXCD, xcd = wgid % NXCD, off = wgid / NXCD; wgid = (xcd < r ? xcd * (q + 1) : r * (q + 1) + (xcd - r) * q) + off; }
        const int nig = WGM * nN, gid = wgid / nig, fm = gid * WGM, gsz = (nM - fm) < WGM ? (nM - fm) : WGM;
        u.pm = fm + ((wgid % nig) % gsz); u.pn = (wgid % nig) / gsz; return true;
    }
    __device__ __forceinline__ void a_ready(const Unit&) const {}
    __device__ __forceinline__ void done(const Unit&) const {}
};

enum { EP_INPROJ = 0, EP_BF16 = 1, EP_KV = 2, EP_RESX = 3, EP_RESH = 4, EP_PLE = 5, EP_BF16S = 6 };
template <int MODE> struct EpiG {
    static constexpr bool PERM = true, AFTER_DRAIN = false;
    bf16_t* o0; bf16_t* o1; float* f0; const float* c0; const bf16_t* b0; int ldc; const float* w1; unsigned long long* ss;
    __device__ __forceinline__ static u32x4 pack8(f32x4 a, f32x4 b) { u32x4 w; w.x = ::cvtpk(a[0], a[1]); w.y = ::cvtpk(a[2], a[3]); w.z = ::cvtpk(b[0], b[1]); w.w = ::cvtpk(b[2], b[3]); return w; }
    __device__ __forceinline__ void emit(int row, int col, f32x4 v0, f32x4 v1) const {
        if constexpr (MODE == EP_INPROJ) {
        } else if constexpr (MODE == EP_BF16) {
            if (w1 != nullptr) __builtin_nontemporal_store(pack8(v0, v1), (u32x4*)(o0 + (size_t)row * ldc + col));
            else *(u32x4*)(o0 + (size_t)row * ldc + col) = pack8(v0, v1);
        } else if constexpr (MODE == EP_KV) {
            if (col < 2048) *(u32x4*)(o0 + (size_t)row * 2048 + col) = pack8(v0, v1);
            else *(u32x4*)(o1 + (size_t)row * 2048 + (col - 2048)) = pack8(v0, v1);
        } else if constexpr (MODE == EP_PLE) {
            if (ldc) return;
            const size_t off = (size_t)row * 2048 + col; const f32x4 a = *(const f32x4*)(f0 + off), b = *(const f32x4*)(f0 + off + 4);
            const f32x4 g0 = *(const f32x4*)(c0 + col), g1 = *(const f32x4*)(c0 + col + 4); const u32x4 pw = __builtin_nontemporal_load((const u32x4*)(b0 + off));
            f32x4 r0, r1;
            r0[0] = a[0] + ::sigmoidf_(v0[0] + g0[0]) * ::bflo(pw.x); r0[1] = a[1] + ::sigmoidf_(v0[1] + g0[1]) * ::bfhi(pw.x);
            r0[2] = a[2] + ::sigmoidf_(v0[2] + g0[2]) * ::bflo(pw.y); r0[3] = a[3] + ::sigmoidf_(v0[3] + g0[3]) * ::bfhi(pw.y);
            r1[0] = b[0] + ::sigmoidf_(v1[0] + g1[0]) * ::bflo(pw.z); r1[1] = b[1] + ::sigmoidf_(v1[1] + g1[1]) * ::bfhi(pw.z);
            r1[2] = b[2] + ::sigmoidf_(v1[2] + g1[2]) * ::bflo(pw.w); r1[3] = b[3] + ::sigmoidf_(v1[3] + g1[3]) * ::bfhi(pw.w);
            *(f32x4*)(f0 + off) = r0; *(f32x4*)(f0 + off + 4) = r1;
        }
    }
    __device__ __forceinline__ void operator()(const f32x4 (&acc)[2][2][4][2], const Unit& u, int wr, int wc, int fr, int fq) const {
        const int row0 = u.pm * BM + wr * 64 + fr, colb = u.pn * BM + wc * 32 + 8 * fq;
        if constexpr (MODE == EP_INPROJ) {
            if (u.pn < 40) {
                bf16_t* base; int ld, c0_;
                if (u.pn < 16) { base = o0; ld = 4096; c0_ = colb; } else { base = o1; ld = 6144; c0_ = colb - 4096; }
#pragma unroll
                for (int ai = 0; ai < 2; ++ai)
#pragma unroll
                    for (int m = 0; m < 4; ++m) { bf16_t* rp = base + (size_t)(row0 + ai * HALF + m * 16) * ld + c0_;
#pragma unroll
                        for (int bj = 0; bj < 2; ++bj) __builtin_nontemporal_store(pack8(acc[ai][bj][m][0], acc[ai][bj][m][1]), (u32x4*)(rp + bj * HALF)); }
            } else if (wc < 2) {
                const int c = wc * 32 + 8 * fq;
#pragma unroll
                for (int ai = 0; ai < 2; ++ai)
#pragma unroll
                    for (int m = 0; m < 4; ++m) { float* rp = f0 + (size_t)(row0 + ai * HALF + m * 16) * 64 + c; *(f32x4*)rp = acc[ai][0][m][0]; *(f32x4*)(rp + 4) = acc[ai][0][m][1]; }
            }
        } else if constexpr (MODE == EP_RESX || MODE == EP_RESH) {
            if (MODE == EP_RESH && ldc) return;
            f32x4 wv[2][2];
#pragma unroll
            for (int bj = 0; bj < 2; ++bj) { wv[bj][0] = *(const f32x4*)(w1 + colb + bj * HALF); wv[bj][1] = *(const f32x4*)(w1 + colb + bj * HALF + 4); }
            const float* R = MODE == EP_RESX ? c0 : f0;
#pragma unroll
            for (int ai = 0; ai < 2; ++ai)
#pragma unroll
                for (int m = 0; m < 4; ++m) { const int row = row0 + ai * HALF + m * 16; float sq = 0.f;
#pragma unroll
                    for (int bj = 0; bj < 2; ++bj) { const size_t off = (size_t)row * 2048 + colb + bj * HALF;
                        f32x4 v0 = acc[ai][bj][m][0], v1 = acc[ai][bj][m][1];
                        if (MODE == EP_RESX && ldc) { v0 = v0 * 0.f; v1 = v1 * 0.f; }
                        const f32x4 r0 = *(const f32x4*)(R + off) + v0, r1 = *(const f32x4*)(R + off + 4) + v1;
                        *(f32x4*)(f0 + off) = r0; *(f32x4*)(f0 + off + 4) = r1;
                        sq += (r0[0] * r0[0] + r0[1] * r0[1]) + (r0[2] * r0[2] + r0[3] * r0[3]) + (r1[0] * r1[0] + r1[1] * r1[1]) + (r1[2] * r1[2] + r1[3] * r1[3]);
                        *(u32x4*)(o0 + off) = pack8(r0 * wv[bj][0], r1 * wv[bj][1]); }
                    sq += __shfl_xor(sq, 16); sq += __shfl_xor(sq, 32);
                    if (fq == 0) atomicAdd(ss + row, (unsigned long long)(unsigned)(sq * ::SS_FIX)); }
        } else if constexpr (MODE == EP_BF16S) {
#pragma unroll
            for (int ai = 0; ai < 2; ++ai)
#pragma unroll
                for (int m = 0; m < 4; ++m) { const int row = row0 + ai * HALF + m * 16;
                    const float rs = ::ss_rstd(ss[row]);
#pragma unroll
                    for (int bj = 0; bj < 2; ++bj) *(u32x4*)(o0 + (size_t)row * ldc + colb + bj * HALF) = pack8(acc[ai][bj][m][0] * rs, acc[ai][bj][m][1] * rs); }
        } else {
#pragma unroll
        for (int ai = 0; ai < 2; ++ai)
#pragma unroll
            for (int m = 0; m < 4; ++m)
#pragma unroll
                for (int bj = 0; bj < 2; ++bj) emit(row0 + ai * HALF + m * 16, colb + bj * HALF, acc[ai][bj][m][0], acc[ai][bj][m][1]);
        }
    }
};

struct EpiFin {
    static constexpr bool PERM = true, AFTER_DRAIN = true;
    const float* H; const float* gb; const bf16_t* pp; const float* fw; unsigned long long* ss; unsigned* cnt; float* out; int dry;
    template <class LDS>
    __device__ __forceinline__ void fused(f32x4 (&acc)[2][2][4][2], const Unit& u, int wr, int wc, int fr_, int fq_, LDS, int, int lane_) const {
        if (dry) return;
        int le = lane_; asm volatile("" : "+v"(le)); const int fr = le & 15, fq = le >> 4; (void)fr_; (void)fq_;
        const int row0 = u.pm * BM + wr * 64 + fr, colb = u.pn * BM + wc * 32 + 8 * fq;
#pragma unroll
        for (int bj = 0; bj < 2; ++bj) { const int col = colb + bj * HALF; const f32x4 g0 = *(const f32x4*)(gb + col), g1 = *(const f32x4*)(gb + col + 4);
#pragma unroll
            for (int ai = 0; ai < 2; ++ai)
#pragma unroll
                for (int m = 0; m < 4; ++m) { const unsigned eo = (unsigned)(row0 + ai * HALF + m * 16) * 2048u + (unsigned)col;
                    const f32x4 a = *(const f32x4*)((const char*)H + eo * 4u), b = *(const f32x4*)((const char*)H + eo * 4u + 16u); const u32x4 pw = __builtin_nontemporal_load((const u32x4*)((const char*)pp + eo * 2u)); const f32x4 v0 = acc[ai][bj][m][0], v1 = acc[ai][bj][m][1];
                    f32x4 r0, r1;
                    r0[0] = a[0] + ::sigmoidf_(v0[0] + g0[0]) * ::bflo(pw.x); r0[1] = a[1] + ::sigmoidf_(v0[1] + g0[1]) * ::bfhi(pw.x);
                    r0[2] = a[2] + ::sigmoidf_(v0[2] + g0[2]) * ::bflo(pw.y); r0[3] = a[3] + ::sigmoidf_(v0[3] + g0[3]) * ::bfhi(pw.y);
                    r1[0] = b[0] + ::sigmoidf_(v1[0] + g1[0]) * ::bflo(pw.z); r1[1] = b[1] + ::sigmoidf_(v1[1] + g1[1]) * ::bfhi(pw.z);
                    r1[2] = b[2] + ::sigmoidf_(v1[2] + g1[2]) * ::bflo(pw.w); r1[3] = b[3] + ::sigmoidf_(v1[3] + g1[3]) * ::bfhi(pw.w);
                    acc[ai][bj][m][0] = r0; acc[ai][bj][m][1] = r1;
                    if (m == 3) asm volatile("" : "+v"(acc[ai][bj][0][0]), "+v"(acc[ai][bj][0][1]), "+v"(acc[ai][bj][1][0]), "+v"(acc[ai][bj][1][1]), "+v"(acc[ai][bj][2][0]), "+v"(acc[ai][bj][2][1]), "+v"(acc[ai][bj][3][0]), "+v"(acc[ai][bj][3][1]) :: "memory"); } }
#pragma unroll
        for (int ai = 0; ai < 2; ++ai)
#pragma unroll
            for (int m = 0; m < 4; ++m) { float sq = 0.f;
#pragma unroll
                for (int bj = 0; bj < 2; ++bj) { const f32x4 r0 = acc[ai][bj][m][0], r1 = acc[ai][bj][m][1];
                    sq += (r0[0] * r0[0] + r0[1] * r0[1]) + (r0[2] * r0[2] + r0[3] * r0[3]) + (r1[0] * r1[0] + r1[1] * r1[1]) + (r1[2] * r1[2] + r1[3] * r1[3]); }
                sq += __shfl_xor(sq, 16); sq += __shfl_xor(sq, 32);
                if (fq == 0) { const unsigned long long o_ = atomicAdd(ss + row0 + ai * HALF + m * 16, (unsigned long long)(unsigned)(sq * ::SS_FIX)); asm volatile("" :: "v"(o_)); } }
        asm volatile("s_waitcnt vmcnt(0)" ::: "memory");
        __syncthreads();
        if (le == 0 && wr == 0 && wc == 0) {
            __hip_atomic_fetch_add(cnt + u.pm, 1u, __ATOMIC_RELAXED, __HIP_MEMORY_SCOPE_AGENT);
            unsigned sp = 0; while (__hip_atomic_load(cnt + u.pm, __ATOMIC_RELAXED, __HIP_MEMORY_SCOPE_AGENT) < 8u) { __builtin_amdgcn_s_sleep(1); if (++sp > (1u << 24)) break; }
        }
        __syncthreads();
#pragma unroll
        for (int bj = 0; bj < 2; ++bj) { const int col = colb + bj * HALF; const f32x4 w0 = *(const f32x4*)(fw + col), w1_ = *(const f32x4*)(fw + col + 4);
#pragma unroll
            for (int ai = 0; ai < 2; ++ai)
#pragma unroll
                for (int m = 0; m < 4; ++m) { const int row = row0 + ai * HALF + m * 16; const float rs = ::ss_rstd(__hip_atomic_load(ss + row, __ATOMIC_RELAXED, __HIP_MEMORY_SCOPE_AGENT));
                    float* op = out + (size_t)row * 2048 + col; *(f32x4*)op = acc[ai][bj][m][0] * rs * w0; *(f32x4*)(op + 4) = acc[ai][bj][m][1] * rs * w1_; } }
    }
};
template <class Epi, class Sched, bool ALIGN_EPI = false, bool SP2 = false, bool FP8 = false>
__device__ __forceinline__ void gemm_phase(PG8_LAS unsigned char* lds, const Gemm g, const Sched& S, const Epi& E, const int tid) {
    const int wid = __builtin_amdgcn_readfirstlane(tid >> 6), lane = tid & 63, wr = wid >> 2, wc = wid & 3, fr = lane & 15, fq = lane >> 4;
    const int K = g.K, nt = FP8 ? K / (2 * BK) : K / BK;
    unsigned voffA[2], voffB[2];
#pragma unroll
    for (int i = 0; i < 2; ++i) { int R, C; stage_rc(tid * 16 + i * 8192, R, C); const int Rb = Epi::PERM ? ((R & ~31) + perm32(R & 31)) : R;
        voffA[i] = FP8 ? (unsigned)(R * K + C * 2) : (unsigned)(R * K + C) * 2u; voffB[i] = FP8 ? (unsigned)(Rb * K + C * 2) : (unsigned)(Rb * K + C) * 2u; }
    const size_t kstep = (size_t)(BK * 2);
    const size_t hstep = (size_t)HALF * K * (FP8 ? 1 : 2);
    const size_t tstep = 2 * hstep;
    const unsigned ldsw = (unsigned)wid * 1024u;
    const int aoff = lds_byte(wr * 64 + fr, fq * 8), boff = lds_byte(wc * 32 + fr, fq * 8);
typedef int pg8_i32x8 __attribute__((ext_vector_type(8)));
#define PG8_CAT(x, y) __builtin_bit_cast(pg8_i32x8, __builtin_shufflevector(x, y, 0, 1, 2, 3, 4, 5, 6, 7, 8, 9, 10, 11, 12, 13, 14, 15))
#define PG8_SA(b, h) (((b) * 2 + (h)) * HTB)
#define PG8_SB(b, h) ((4 + (b) * 2 + (h)) * HTB)
#define PG8_STAGE(bufoff, gbase, voff) do { _Pragma("unroll") for (int _i = 0; _i < 2; ++_i) \
        __builtin_amdgcn_global_load_lds((const unsigned*)((const char*)(gbase) + (voff)[_i]), (PG8_LAS unsigned*)(lds + (bufoff) + ldsw + _i * 8192), 16, 0, 0); } while (0)
#define PG8_LDA(dst, b, h) do { if constexpr (FP8) { _Pragma("unroll") for (int m = 0; m < 4; ++m) dst##8[m] = PG8_CAT(*(const PG8_LAS bf16x8*)(lds + PG8_SA(b, h) + aoff + m * 2048), *(const PG8_LAS bf16x8*)(lds + PG8_SA(b, h) + aoff + m * 2048 + 1024)); } \
    else { _Pragma("unroll") for (int m = 0; m < 4; ++m) _Pragma("unroll") for (int k = 0; k < 2; ++k) dst[m][k] = *(const PG8_LAS bf16x8*)(lds + PG8_SA(b, h) + aoff + m * 2048 + k * 1024); } } while (0)
#define PG8_LDB(dst, b, h) do { if constexpr (FP8) { _Pragma("unroll") for (int n = 0; n < 2; ++n) dst##8[n] = PG8_CAT(*(const PG8_LAS bf16x8*)(lds + PG8_SB(b, h) + boff + n * 2048), *(const PG8_LAS bf16x8*)(lds + PG8_SB(b, h) + boff + n * 2048 + 1024)); } \
    else { _Pragma("unroll") for (int n = 0; n < 2; ++n) _Pragma("unroll") for (int k = 0; k < 2; ++k) dst[n][k] = *(const PG8_LAS bf16x8*)(lds + PG8_SB(b, h) + boff + n * 2048 + k * 1024); } } while (0)
#define PG8_MMA(ai, bj, At, Bt) do { __builtin_amdgcn_s_setprio(1); \
        if constexpr (FP8) { asm volatile("s_nop 1"); _Pragma("unroll") for (int m = 0; m < 4; ++m) _Pragma("unroll") for (int n = 0; n < 2; ++n) \
            asm volatile("v_mfma_scale_f32_16x16x128_f8f6f4 %0, %1, %2, %0, %3, %4 op_sel_hi:[0,0,0]" : "+v"(acc[ai][bj][m][n]) : "v"(Bt##8[n]), "v"(At##8[m]), "v"(sc_w), "v"(sc_a)); } \
        else { _Pragma("unroll") for (int m = 0; m < 4; ++m) _Pragma("unroll") for (int n = 0; n < 2; ++n) _Pragma("unroll") for (int k = 0; k < 2; ++k) \
            acc[ai][bj][m][n] = __builtin_amdgcn_mfma_f32_16x16x32_bf16(Bt[n][k], At[m][k], acc[ai][bj][m][n], 0, 0, 0); } \
        __builtin_amdgcn_s_setprio(0); } while (0)
#define PG8_WAIT_V(n) asm volatile("s_waitcnt vmcnt(" #n ")" ::: "memory")
#define PG8_WAIT_L(n) asm volatile("s_waitcnt lgkmcnt(" #n ")" ::: "memory")
#define PG8_BAR __builtin_amdgcn_s_barrier()
#define PG8_SCHED __builtin_amdgcn_sched_barrier(0)
    Unit cur, nxt; int ui = 0;
    if (!S.next(0, cur)) return;
    f32x4 acc[2][2][4][2];
#pragma unroll
    for (int a = 0; a < 2; ++a)
#pragma unroll
        for (int b = 0; b < 2; ++b)
#pragma unroll
            for (int m = 0; m < 4; ++m)
#pragma unroll
                for (int n = 0; n < 2; ++n) acc[a][b][m][n] = (f32x4){0.f, 0.f, 0.f, 0.f};
    bf16x8 At[4][2], B0[2][2], B1[2][2]; pg8_i32x8 At8[4], B08[2], B18[2];
    int sc_w = 0x79797979, sc_a = 0x7f7f7f7f; asm volatile("" : "+v"(sc_w), "+v"(sc_a));
    const char* cA = (const char*)g.A + (size_t)cur.pm * tstep; const char* cB = (const char*)g.Bt + (size_t)cur.pn * tstep;
    S.a_ready(cur);
    if constexpr (SP2) {
        PG8_STAGE(PG8_SB(0, 0), cB, voffB); PG8_STAGE(PG8_SB(0, 1), cB + hstep, voffB); PG8_STAGE(PG8_SA(0, 0), cA, voffA); PG8_STAGE(PG8_SA(0, 1), cA + hstep, voffA);
        if (wr == 1) PG8_BAR;
        PG8_WAIT_V(2); PG8_BAR;
        PG8_STAGE(PG8_SB(1, 0), cB + kstep, voffB); PG8_STAGE(PG8_SA(1, 0), cA + kstep, voffA); PG8_STAGE(PG8_SB(1, 1), cB + hstep + kstep, voffB);
        PG8_WAIT_V(6); PG8_BAR;
    } else {
        PG8_STAGE(PG8_SB(0, 0), cB, voffB); PG8_STAGE(PG8_SA(0, 0), cA, voffA); PG8_STAGE(PG8_SB(0, 1), cB + hstep, voffB); PG8_STAGE(PG8_SA(0, 1), cA + hstep, voffA);
        if (wr == 1) PG8_BAR;
        PG8_WAIT_V(4); PG8_BAR;
        PG8_STAGE(PG8_SB(1, 0), cB + kstep, voffB); PG8_STAGE(PG8_SA(1, 0), cA + kstep, voffA); PG8_STAGE(PG8_SB(1, 1), cB + hstep + kstep, voffB);
        PG8_WAIT_V(6); PG8_BAR;
    }
    for (;;) {
        const bool has_next = S.next(ui + 1, nxt);
        const char* nA = has_next ? (const char*)g.A + (size_t)nxt.pm * tstep : cA; const char* nB = has_next ? (const char*)g.Bt + (size_t)nxt.pn * tstep : cB;
        for (int t = 0; t < nt; t += 2) {
            const bool last = (t == nt - 2);
            const char* a1 = cA + (size_t)(t + 1) * kstep;
            const char* a2 = last ? nA : cA + (size_t)(t + 2) * kstep; const char* b2 = last ? nB : cB + (size_t)(t + 2) * kstep;
            const char* a3 = a2 + kstep; const char* b3 = b2 + kstep;
            if (last && has_next) S.a_ready(nxt);
            if constexpr (SP2) {
            PG8_LDB(B0, 0, 0); PG8_LDB(B1, 0, 1); PG8_SCHED; PG8_LDA(At, 0, 0); PG8_STAGE(PG8_SA(1, 1), a1 + hstep, voffA);
            PG8_WAIT_V(8); PG8_WAIT_L(0); PG8_BAR; PG8_MMA(0, 0, At, B0); PG8_MMA(0, 1, At, B1); PG8_BAR; PG8_SCHED;
            PG8_LDA(At, 0, 1); PG8_STAGE(PG8_SB(0, 0), b2, voffB); PG8_STAGE(PG8_SB(0, 1), b2 + hstep, voffB); PG8_STAGE(PG8_SA(0, 0), a2, voffA);
            PG8_WAIT_V(8); PG8_WAIT_L(0); PG8_BAR; PG8_MMA(1, 0, At, B0); PG8_MMA(1, 1, At, B1); PG8_BAR; PG8_SCHED;
            PG8_LDB(B0, 1, 0); PG8_LDB(B1, 1, 1); PG8_SCHED; PG8_LDA(At, 1, 0); PG8_STAGE(PG8_SA(0, 1), a2 + hstep, voffA);
            PG8_WAIT_V(8); PG8_WAIT_L(0); PG8_BAR; PG8_MMA(0, 0, At, B0); PG8_MMA(0, 1, At, B1); PG8_BAR; PG8_SCHED;
            PG8_LDA(At, 1, 1); PG8_STAGE(PG8_SB(1, 0), b3, voffB); PG8_STAGE(PG8_SB(1, 1), b3 + hstep, voffB); PG8_STAGE(PG8_SA(1, 0), a3, voffA);
            PG8_WAIT_V(8); PG8_WAIT_L(0); PG8_BAR; PG8_MMA(1, 0, At, B0); PG8_MMA(1, 1, At, B1); PG8_BAR; PG8_SCHED;
            } else {
            PG8_LDB(B0, 0, 0); PG8_SCHED; PG8_LDA(At, 0, 0); PG8_STAGE(PG8_SA(1, 1), a1 + hstep, voffA);
            PG8_WAIT_L(8); PG8_BAR; PG8_WAIT_L(0); PG8_MMA(0, 0, At, B0); PG8_BAR; PG8_SCHED;
            PG8_LDB(B1, 0, 1); PG8_STAGE(PG8_SB(0, 0), b2, voffB);
            PG8_BAR; PG8_WAIT_L(0); PG8_MMA(0, 1, At, B1); PG8_BAR;
            PG8_LDA(At, 0, 1); PG8_STAGE(PG8_SA(0, 0), a2, voffA);
            PG8_BAR; PG8_WAIT_L(0); PG8_MMA(1, 0, At, B0); PG8_BAR; PG8_SCHED;
            PG8_STAGE(PG8_SB(0, 1), b2 + hstep, voffB);
            PG8_WAIT_V(6); PG8_BAR; PG8_MMA(1, 1, At, B1); PG8_BAR;
            PG8_LDB(B0, 1, 0); PG8_SCHED; PG8_LDA(At, 1, 0); PG8_STAGE(PG8_SA(0, 1), a2 + hstep, voffA);
            PG8_WAIT_L(8); PG8_BAR; PG8_WAIT_L(0); PG8_MMA(0, 0, At, B0); PG8_BAR; PG8_SCHED;
            PG8_LDB(B1, 1, 1); PG8_STAGE(PG8_SB(1, 0), b3, voffB);
            PG8_BAR; PG8_WAIT_L(0); PG8_MMA(0, 1, At, B1); PG8_BAR;
            PG8_LDA(At, 1, 1); PG8_STAGE(PG8_SA(1, 0), a3, voffA);
            PG8_BAR; PG8_WAIT_L(0); PG8_MMA(1, 0, At, B0); PG8_BAR; PG8_SCHED;
            PG8_STAGE(PG8_SB(1, 1), b3 + hstep, voffB);
            PG8_WAIT_V(6); PG8_BAR; PG8_MMA(1, 1, At, B1); PG8_BAR;
            }
        }
        if constexpr (ALIGN_EPI) { if (wr == 0) PG8_BAR; }
        if constexpr (FP8) asm volatile("s_nop 15\n\ts_nop 7" ::: "memory");
        if constexpr (!Epi::AFTER_DRAIN) { int le_ = lane; asm volatile("" : "+v"(le_)); E(acc, cur, wr, wc, le_ & 15, le_ >> 4); S.done(cur); }
        if (!has_next) break;
#pragma unroll
        for (int a = 0; a < 2; ++a)
#pragma unroll
            for (int b = 0; b < 2; ++b)
#pragma unroll
                for (int m = 0; m < 4; ++m)
#pragma unroll
                    for (int n = 0; n < 2; ++n) acc[a][b][m][n] = (f32x4){0.f, 0.f, 0.f, 0.f};
        cur = nxt; cA = nA; cB = nB; ++ui;
        if constexpr (ALIGN_EPI) { if (wr == 1) PG8_BAR; }
    }
    PG8_WAIT_V(0);
    if constexpr (!ALIGN_EPI) { if (wr == 0) PG8_BAR; }
    PG8_BAR;
    if constexpr (Epi::AFTER_DRAIN) { E.fused(acc, cur, wr, wc, fr, fq, lds, wid, lane); S.done(cur); }
#undef PG8_SA
#undef PG8_CAT
#undef PG8_SB
#undef PG8_STAGE
#undef PG8_LDA
#undef PG8_LDB
#undef PG8_MMA
#undef PG8_WAIT_V
#undef PG8_WAIT_L
#undef PG8_BAR
#undef PG8_SCHED
}
}
namespace fox {
constexpr int D = 128, RS = 2048;
constexpr float SCALE = 0.08838834764831845f;
constexpr float THR = 8.f;
constexpr int NW = 8, QBLK = 32, KVBLK = 64, QB = NW * QBLK;
constexpr int SHM_V = KVBLK * D * 2, SHM_K = KVBLK * D * 2;
constexpr int LDS_BYTES = 2 * SHM_V + 2 * SHM_K + NW * 64 * 4;
#define KSWZ(row, colB) ((row) * 256 + ((colB) ^ (((row) & 7) << 4)))
__device__ __forceinline__ int v_st(int k, int c) { const int kk = (k & ~0xC) | ((k & 4) << 1) | ((k & 8) >> 1); return ((kk >> 3) * 4 + (c >> 5)) * 512 + ((kk & 7) * 32 + (c & 31)) * 2; }
__device__ __forceinline__ int v_rd_base(int lane) { return ((lane & 3) << 3) | (((lane >> 2) & 3) << 6) | (((lane >> 4) & 1) << 5) | (((lane >> 5) & 1) << 8); }
constexpr int v_rd_off(int d0, int ks, int half) { return d0 * 512 + ks * 4096 + half * 2048; }
__device__ __forceinline__ int crow(int r, int hi) { return (r & 3) + 8 * (r >> 2) + 4 * hi; }
__device__ __forceinline__ bf16x8 load8(const bf16* p) { return *reinterpret_cast<const bf16x8*>(p); }
__device__ __forceinline__ void mask_tile(f32x16& p0, f32x16& p1, int dq, unsigned W) {
    const float NEG = -__builtin_inff();
#pragma unroll
    for (int r = 0; r < 16; ++r) {
        const int c = (r & 3) + 8 * (r >> 2);
        if ((unsigned)(dq - c) >= W) p0[r] = NEG;
        if ((unsigned)(dq - c - 32) >= W) p1[r] = NEG;
    }
}
__device__ __forceinline__ void partialSM(f32x16& p0, f32x16& p1, float& m_reg, float& alpha) { float mn;
    float pmax = p0[0]; for (int r = 1; r < 16; ++r) pmax = fmaxf(pmax, p0[r]); for (int r = 0; r < 16; ++r) pmax = fmaxf(pmax, p1[r]);
    { auto rr = __builtin_amdgcn_permlane32_swap(__float_as_uint(pmax), __float_as_uint(pmax), false, false);
      pmax = fmaxf(__uint_as_float(rr[0]), __uint_as_float(rr[1])); }
    constexpr float C2 = 1.4426950408889634f * SCALE;
    if (__builtin_expect(__all((pmax - m_reg) * SCALE <= THR), 1)) { mn = m_reg; alpha = 1.f; }
    else { mn = fmaxf(m_reg, pmax); alpha = __builtin_amdgcn_exp2f((m_reg - mn) * C2); m_reg = mn; }
    const float mnL = -mn * C2;
    for (int r = 0; r < 16; ++r) p0[r] = fmaf(p0[r], C2, mnL); for (int r = 0; r < 16; ++r) p1[r] = fmaf(p1[r], C2, mnL);
    for (int r = 0; r < 16; ++r) p0[r] = __builtin_amdgcn_exp2f(p0[r]);
}
#define FOX_PK4(P, B_, OUT) do { unsigned a0 = cvtpk(P[B_+0], P[B_+1]), a1 = cvtpk(P[B_+2], P[B_+3]);                          \
        unsigned b0 = cvtpk(P[B_+4], P[B_+5]), b1 = cvtpk(P[B_+6], P[B_+7]);                                             \
        auto r0 = __builtin_amdgcn_permlane32_swap(a0, b0, false, false); auto r1 = __builtin_amdgcn_permlane32_swap(a1, b1, false, false); \
        v4u w = {r0[0], r1[0], r0[1], r1[1]}; OUT = *reinterpret_cast<bf16x8*>(&w); } while (0)
__device__ __forceinline__ void finishSM(f32x16& p0, f32x16& p1, float alpha, float& l_reg, bf16x8& pa0, bf16x8& pa1, bf16x8& pa2, bf16x8& pa3) {
    for (int r = 0; r < 16; ++r) p1[r] = __builtin_amdgcn_exp2f(p1[r]);
    float ps = 0; for (int r = 0; r < 16; ++r) ps += p0[r]; for (int r = 0; r < 16; ++r) ps += p1[r];
    { auto rr = __builtin_amdgcn_permlane32_swap(__float_as_uint(ps), __float_as_uint(ps), false, false);
      ps = __uint_as_float(rr[0]) + __uint_as_float(rr[1]); }
    l_reg = l_reg * alpha + ps;
    FOX_PK4(p0, 0, pa0); FOX_PK4(p0, 8, pa1); FOX_PK4(p1, 0, pa2); FOX_PK4(p1, 8, pa3);
}
template <int KB>
__device__ __forceinline__ void qkt(f32x16& p0, f32x16& p1, const char* K_lds, int r32, int hi, const bf16x8* qr) {
    const char* kb[4];
#pragma unroll
    for (int dd = 0; dd < 4; ++dd) kb[dd] = K_lds + KB * SHM_K + KSWZ(r32, (dd * 16 + hi * 8) * 2);
#pragma unroll
    for (int d0 = 0; d0 < 8; ++d0) { const char* a = kb[d0 & 3] + (d0 >> 2) * 128;
        bf16x8 b0 = *reinterpret_cast<const bf16x8*>(a);
        bf16x8 b1 = *reinterpret_cast<const bf16x8*>(a + 32 * 256);
        p0 = __builtin_amdgcn_mfma_f32_32x32x16_bf16(b0, qr[d0], p0, 0, 0, 0);
        p1 = __builtin_amdgcn_mfma_f32_32x32x16_bf16(b1, qr[d0], p1, 0, 0, 0); }
}
#define FOX_TRRD(dst, off) asm volatile("ds_read_b64_tr_b16 %0, %1 offset:%2" : "=&v"(dst) : "v"(vb0), "i"(off) : "memory")
#define FOX_PV_D0(d0, VB) do { s16x4 l0, l1, l2, l3, h0, h1, h2, h3; constexpr int b_ = (VB) * SHM_V + v_rd_off(d0, 0, 0);   \
        FOX_TRRD(l0, b_); FOX_TRRD(h0, b_ + 2048); FOX_TRRD(l1, b_ + 4096); FOX_TRRD(h1, b_ + 6144); FOX_TRRD(l2, b_ + 8192); FOX_TRRD(h2, b_ + 10240); FOX_TRRD(l3, b_ + 12288); FOX_TRRD(h3, b_ + 14336); \
        asm volatile("s_waitcnt lgkmcnt(0)" ::: "memory"); SBAR();   \
        o[d0] = __builtin_amdgcn_mfma_f32_32x32x16_bf16(pa0, (bf16x8){l0[0], l0[1], l0[2], l0[3], h0[0], h0[1], h0[2], h0[3]}, o[d0], 0, 0, 0);   \
        o[d0] = __builtin_amdgcn_mfma_f32_32x32x16_bf16(pa1, (bf16x8){l1[0], l1[1], l1[2], l1[3], h1[0], h1[1], h1[2], h1[3]}, o[d0], 0, 0, 0);   \
        o[d0] = __builtin_amdgcn_mfma_f32_32x32x16_bf16(pa2, (bf16x8){l2[0], l2[1], l2[2], l2[3], h2[0], h2[1], h2[2], h2[3]}, o[d0], 0, 0, 0);   \
        o[d0] = __builtin_amdgcn_mfma_f32_32x32x16_bf16(pa3, (bf16x8){l3[0], l3[1], l3[2], l3[3], h3[0], h3[1], h3[2], h3[3]}, o[d0], 0, 0, 0); } while (0)
template <int VB>
__device__ __forceinline__ void pv_tile(f32x16* o, int vb0, bf16x8 pa0, bf16x8 pa1, bf16x8 pa2, bf16x8 pa3) {
    FOX_PV_D0(0, VB); FOX_PV_D0(1, VB); FOX_PV_D0(2, VB); FOX_PV_D0(3, VB);
}

struct BlockRef { const bf16* Q; const bf16* K; const bf16* V; bf16* O; float* ML; int P0, jlo, jhi; };
struct Seam { bf16x8 qr[8]; bf16x8 st_v0, st_v1, st_k0, st_k1; };
#define ROW(p, k0, rr) (((p) + (size_t)(k0) * RS) + (unsigned)((rr) * RS + sc))
#define VMW() asm volatile("s_waitcnt vmcnt(0)" ::: "memory")
#define VMWN(n) asm volatile("s_waitcnt vmcnt(%0)" :: "i"(n) : "memory")
#define SLOAD_H(Kp, Vp, k0) do { S.st_v0 = load8(ROW(Vp, k0, sr)); S.st_v1 = load8(ROW(Vp, k0, 32 + sr));              \
                         S.st_k0 = load8(ROW(Kp, k0, sr)); S.st_k1 = load8(ROW(Kp, k0, 32 + sr)); } while (0)
#define SWRITE_HK(bf) do { *(bf16x8*)(K_lds + (bf) * SHM_K + kws) = S.st_k0; *(bf16x8*)(K_lds + (bf) * SHM_K + kws + 32 * 256) = S.st_k1; } while (0)
#define SWRITE_HV(bf) do { *(bf16x8*)(V_lds + (bf) * SHM_V + vst0) = S.st_v0; *(bf16x8*)(V_lds + (bf) * SHM_V + vst1) = S.st_v1; } while (0)
#define SWRITE_H(bf) do { SWRITE_HV(bf); SWRITE_HK(bf); } while (0)
#define BIASLD(P0_, P1_, kb_) do { const float* nb_ = nbl + (kb_) + 4 * hi; _Pragma("unroll") for (int j_ = 0; j_ < 4; ++j_) { const f32x4 a_ = *(const f32x4*)(nb_ + 8 * j_), b_ = *(const f32x4*)(nb_ + 32 + 8 * j_); \
        P0_[4 * j_] = a_[0]; P0_[4 * j_ + 1] = a_[1]; P0_[4 * j_ + 2] = a_[2]; P0_[4 * j_ + 3] = a_[3]; P1_[4 * j_] = b_[0]; P1_[4 * j_ + 1] = b_[1]; P1_[4 * j_ + 2] = b_[2]; P1_[4 * j_ + 3] = b_[3]; } } while (0)
constexpr int NPERHEAD = 48, NITEM = 16 * NPERHEAD;
__device__ __forceinline__ int item_code(int k) {
    constexpr unsigned char tab[48] = {124, 125, 62, 120, 121, 116, 117, 58, 112, 113, 108, 109, 54, 104, 105, 100, 101, 50, 96, 97, 92, 93, 46, 88, 89, 84, 85, 42, 80, 81, 76, 77, 38, 72, 73, 68, 69, 34, 64, 65, 30, 26, 22, 18, 14, 10, 6, 2};
    return __builtin_amdgcn_readfirstlane((int)tab[k]);
}
struct ItemQ { unsigned* tick; volatile LAS unsigned* bc; const float* NB; const unsigned* NORM; const bf16* Q; const bf16* K; const bf16* V; bf16* O; bf16* OP; float* ML; int xq; };
__device__ __forceinline__ int item_head(int it) { return 2 * (it / 96) + ((it % 96) >= NPERHEAD ? 1 : 0); }
__device__ __forceinline__ int q_pull(const ItemQ& q, const int tid) {
    if (tid == 0) { unsigned r = (unsigned)NITEM;
        for (int a = 0; a < 8; ++a) { const unsigned qx = (unsigned)(q.xq + a) & 7u; const unsigned k = atomicAdd(q.tick + 64 * qx, 1u); if (k < 96u) { r = qx * 96u + k; break; } }
        q.bc[0] = r; }
    __syncthreads(); const int it = __builtin_amdgcn_readfirstlane((int)q.bc[0]); __syncthreads();
    return it;
}
__device__ __forceinline__ BlockRef q_ref(const ItemQ& q, int it, int lane) {
    const int hd = item_head(it), code = item_code((it % 96) % NPERHEAD), qb = code >> 2, part = code & 3; const float* nbh = q.NB + (size_t)hd * 8192;
    const float braw = sqrtf(__uint_as_float(q.NORM[hd]) * __uint_as_float(q.NORM[16 + hd])), thr = -(104.5f / SCALE + 2.f * braw), ref = nbh[qb * QB];
    const int nt = 4 * (qb + 1);
    const bool s0 = (lane < nt) && (nbh[(unsigned)(64 * lane + 63)] - ref < thr), s1 = (lane + 64 < nt) && (nbh[(unsigned)(64 * (lane + 64) + 63)] - ref < thr);
    int jl = __builtin_amdgcn_readfirstlane(__popcll(__ballot(s0)) + __popcll(__ballot(s1))); if (jl > nt - 4) jl = nt - 4;
    BlockRef r; r.Q = q.Q + (size_t)qb * QB * RS + hd * D; r.K = q.K + hd * D; r.V = q.V + hd * D; r.P0 = qb * QB;
    const size_t oo = (size_t)qb * QB * RS + hd * D;
    if (part == 2) { r.O = q.O + oo; r.ML = nullptr; r.jlo = jl; r.jhi = nt; }
    else { const int d0 = 4 * qb; int j0 = jl < d0 - 1 ? jl : d0 - 1; int jm = j0 + (nt - j0) / 2; if (jm > d0) jm = d0; if (jm < j0 + 1) jm = j0 + 1;
        r.O = q.OP + (size_t)part * 8192 * RS + oo; r.ML = q.ML + (size_t)part * 8192 * 32 + hd * 2;
        if (part == 0) { r.jlo = j0; r.jhi = jm; } else { r.jlo = jm; r.jhi = nt; } }
    return r;
}
__device__ __forceinline__ void causal_prime(const BlockRef& cur, char* lds, Seam& S, const int tid) {
    const int wid = __builtin_amdgcn_readfirstlane(tid >> 6), lane = tid & 63, r32 = lane & 31, hi = lane >> 5;
    const int sr = tid >> 4, sc = (tid & 15) * 8, kws = KSWZ(sr, sc * 2); char* K_lds = lds + 2 * SHM_V;
    const int kb0 = cur.jlo * KVBLK;
    for (int d0 = 0; d0 < 8; ++d0) S.qr[d0] = load8(cur.Q + (unsigned)((wid * QBLK + r32) * RS + d0 * 16 + hi * 8));
    SLOAD_H(cur.K, cur.V, kb0); VMW(); SWRITE_HK(0);
    __syncthreads();
}
__device__ __forceinline__ void causal_block(const BlockRef& cur, BlockRef& nxt, int& itn, const ItemQ& iq, int skv, char* lds, Seam& S, const int tid) {
    const int W = 1 << 30;
    const int wid = __builtin_amdgcn_readfirstlane(tid >> 6), lane = tid & 63, r32 = lane & 31, hi = lane >> 5;
    const int j_lo = cur.jlo;
    const int j_hi = cur.jhi;
    const int NT = j_hi - j_lo;
    const int qlo = cur.P0 + wid * QBLK, qm = qlo + r32 - 4 * hi;
    char* V_lds = lds; char* K_lds = lds + 2 * SHM_V;
    float* ws = (float*)(lds + 2 * SHM_V + 2 * SHM_K) + wid * 64; float* li_l = ws, * al_l = ws + 32; const float* nbl = (const float*)(lds + LDS_BYTES);
    float m_reg = -1e30f, l_reg = 0; f32x16 o[4] = {};
    const int sr = tid >> 4, sc = (tid & 15) * 8, vst0 = v_st(sr, sc), vst1 = v_st(32 + sr, sc), kws = KSWZ(sr, sc * 2);
    const int vb0 = (int)(uintptr_t)V_lds + v_rd_base(lane);
    const bf16* Kh = cur.K; const bf16* Vh = cur.V;
#define RESC(a) do { if (__any((a) < 1.f)) { if (hi == 0) al_l[r32] = (a); asm volatile("s_waitcnt lgkmcnt(0)" ::: "memory");              \
                     for (int d_ = 0; d_ < 4; ++d_) for (int r = 0; r < 16; ++r) o[d_][r] *= al_l[crow(r, hi)]; } } while (0)
#define KBASE(t) ((j_lo + (t)) * KVBLK)
#define MASKT(P0_, P1_, t) do { const int kb_ = KBASE(t); if (kb_ + KVBLK - 1 > qlo) mask_tile(P0_, P1_, qm - kb_, (unsigned)W); } while (0)
    constexpr int NQL = 8;
#define SEAM_K0() do { VMWN(NQL); SWRITE_HK(0); SBAR(); } while (0)
    f32x16 pA0, pA1, pB0, pB1; float alA, alB; bf16x8 pa0, pa1, pa2, pa3;
    SWRITE_HV(0); SBAR();
    if (NT > 1) { SLOAD_H(Kh, Vh, KBASE(1)); }
    SBAR(); BIASLD(pA0, pA1, KBASE(0)); qkt<0>(pA0, pA1, K_lds, r32, hi, S.qr);
    MASKT(pA0, pA1, 0); partialSM(pA0, pA1, m_reg, alA);
    if (NT > 1) { VMW(); SWRITE_H(1); BIASLD(pB0, pB1, KBASE(1)); }
    __syncthreads();
#define HALF_STEP(PX0, PX1, alX, PY0, PY1, alY, t, KB, VB, SB) do {                                                      \
        SBAR(); qkt<KB>(PX0, PX1, K_lds, r32, hi, S.qr);                                             \
        finishSM(PY0, PY1, alY, l_reg, pa0, pa1, pa2, pa3); SBAR();                                                           \
        if ((t) + 1 < NT) { SLOAD_H(Kh, Vh, KBASE((t) + 1)); SBAR(); }                                               \
        pv_tile<VB>(o, vb0, pa0, pa1, pa2, pa3); MASKT(PX0, PX1, (t)); partialSM(PX0, PX1, m_reg, alX);                                        \
        __syncthreads();                                                                                                      \
        if ((t) + 1 < NT) { VMW(); SWRITE_H(SB); }                                                                          \
        RESC(alX); if ((t) + 1 < NT) { BIASLD(PY0, PY1, KBASE((t) + 1)); } __syncthreads(); } while (0)
    for (int t = 1; t + 1 < NT; t += 2) {
        HALF_STEP(pB0, pB1, alB, pA0, pA1, alA, t, 1, 0, 0);
        HALF_STEP(pA0, pA1, alA, pB0, pB1, alB, t + 1, 0, 1, 1);
    }
    const bool even = (NT & 1) == 0;
    if (even) { SBAR(); qkt<1>(pB0, pB1, K_lds, r32, hi, S.qr); SBAR(); }
    { int lt_ = tid; asm volatile("" : "+v"(lt_)); itn = q_pull(iq, lt_); if (itn < NITEM) nxt = q_ref(iq, itn, lt_ & 63); else nxt = cur; }
    const int kbn = nxt.jlo * KVBLK;
    SLOAD_H(nxt.K, nxt.V, kbn); SBAR();
    { int lq_ = lane; asm volatile("" : "+v"(lq_)); const unsigned qo_ = (unsigned)((wid * QBLK + (lq_ & 31)) * RS + (lq_ >> 5) * 8);
#pragma unroll
      for (int d0 = 0; d0 < 8; ++d0) S.qr[d0] = load8(nxt.Q + (qo_ + (unsigned)(d0 * 16))); }
    SBAR();
    finishSM(pA0, pA1, alA, l_reg, pa0, pa1, pa2, pa3); SBAR();
    pv_tile<0>(o, vb0, pa0, pa1, pa2, pa3);
    if (even) { MASKT(pB0, pB1, NT - 1); partialSM(pB0, pB1, m_reg, alB); __syncthreads(); RESC(alB);
        finishSM(pB0, pB1, alB, l_reg, pa0, pa1, pa2, pa3); SBAR(); pv_tile<1>(o, vb0, pa0, pa1, pa2, pa3); }
    SBAR(); SEAM_K0();
    if (hi == 0) li_l[r32] = l_reg; asm volatile("s_waitcnt lgkmcnt(0)" ::: "memory");
    float rli[16];
#pragma unroll
    for (int r = 0; r < 16; ++r) rli[r] = __builtin_amdgcn_rcpf(li_l[crow(r, hi)]);
    bf16* Ow = cur.O;
    { int le_ = lane; asm volatile("" : "+v"(le_)); const int r32e = le_ & 31, hie = le_ >> 5;
      char* stg = lds + LDS_BYTES + 32768 + wid * 2176;
      char* stw = stg + hie * (4 * 272) + r32e * 2; const char* strd = stg + (le_ >> 4) * 272 + (le_ & 15) * 16;
      const unsigned ob_ = (unsigned)((wid * QBLK + (le_ >> 4)) * RS + (le_ & 15) * 8);
#pragma unroll
      for (int q = 0; q < 4; ++q) {
#pragma unroll
        for (int rl = 0; rl < 4; ++rl) { const int r = 4 * q + rl;
#pragma unroll
          for (int d0 = 0; d0 < 4; ++d0) *(unsigned short*)(stw + rl * 272 + d0 * 64) = (unsigned short)cvtpk(o[d0][r] * rli[r], 0.f); }
        asm volatile("s_waitcnt lgkmcnt(0)" ::: "memory");
        const v4u d0_ = *(const v4u*)strd, d1_ = *(const v4u*)(strd + 4 * 272);
        *(v4u*)(Ow + (ob_ + (unsigned)((8 * q) * RS))) = d0_; *(v4u*)(Ow + (ob_ + (unsigned)((8 * q + 4) * RS))) = d1_;
        asm volatile("" ::: "memory"); }
      if (cur.ML != nullptr && hie == 0) { f32x2_t ml = {m_reg, l_reg}; *(f32x2_t*)(cur.ML + (unsigned)((cur.P0 + wid * QBLK + r32e) * 32)) = ml; } }
    __syncthreads();
#undef RESC
#undef KBASE
#undef MASKT
#undef SEAM_K0
#undef HALF_STEP
}
#undef ROW
#undef VMW
#undef VMWN
#undef SLOAD_H
#undef SWRITE_HK
#undef SWRITE_HV
#undef SWRITE_H
#undef BIASLD
}
constexpr int NWAVES_ = 8;
struct Frame {
    LAS unsigned char* lds;
    int tid, lane, wave, bx;
    int vcu, G;
    int gw, NGW;
    int gt, NGT;
};

struct P0Item { const float* W; unsigned char* WT; int K, N, ldw, item, fp8; };
__device__ __forceinline__ void p0_load(const P0Item& I, int lane, float (&tmp)[32]) {
    const int nblk = I.N / 32, kb = I.item / nblk, nb = I.item % nblk, k0 = 64 * kb, n0 = 32 * nb;
#pragma unroll
    for (int i = 0; i < 32; ++i) tmp[i] = __builtin_nontemporal_load(I.W + (size_t)(k0 + 2 * i + (lane >> 5)) * I.ldw + n0 + (lane & 31));
}
__device__ __forceinline__ v2u pack8_fp8(f32x4 a, f32x4 b) {
    int p = __builtin_amdgcn_cvt_pk_fp8_f32(a[0], a[1], 0, false); p = __builtin_amdgcn_cvt_pk_fp8_f32(a[2], a[3], p, true);
    int q = __builtin_amdgcn_cvt_pk_fp8_f32(b[0], b[1], 0, false); q = __builtin_amdgcn_cvt_pk_fp8_f32(b[2], b[3], q, true);
    return (v2u){(unsigned)p, (unsigned)q};
}
__device__ __forceinline__ void p0_emit(const P0Item& I, int lane, const float (&tmp)[32], LAS float* scr) {
    const int nblk = I.N / 32, kb = I.item / nblk, nb = I.item % nblk, k0 = 64 * kb, n0 = 32 * nb, K = I.K;
#pragma unroll
    for (int i = 0; i < 32; ++i) scr[(2 * i + (lane >> 5)) * 33 + (lane & 31)] = tmp[i];
    LDS_WAIT(); asm volatile("" ::: "memory");
    const int c = lane & 7;
    if (I.fp8) {
#pragma unroll
        for (int j = 0; j < 4; ++j) { const int n = (lane >> 3) + 8 * j; const LAS float* s = scr + (8 * c) * 33 + n;
            const f32x4 a = {s[0 * 33] * 64.f, s[1 * 33] * 64.f, s[2 * 33] * 64.f, s[3 * 33] * 64.f}, b = {s[4 * 33] * 64.f, s[5 * 33] * 64.f, s[6 * 33] * 64.f, s[7 * 33] * 64.f};
            *(GAS v2u*)(I.WT + (size_t)(n0 + n) * K + k0 + 8 * c) = pack8_fp8(a, b); }
    } else {
#pragma unroll
        for (int j = 0; j < 4; ++j) { const int n = (lane >> 3) + 8 * j; const LAS float* s = scr + (8 * c) * 33 + n;
            v4u o; o.x = cvtpk(s[0 * 33], s[1 * 33]); o.y = cvtpk(s[2 * 33], s[3 * 33]); o.z = cvtpk(s[4 * 33], s[5 * 33]); o.w = cvtpk(s[6 * 33], s[7 * 33]);
            *(GAS v4u*)((bf16*)I.WT + (size_t)(n0 + n) * K + k0 + 8 * c) = o; }
    }
    LDS_WAIT(); asm volatile("" ::: "memory");
}
__device__ __forceinline__ void cvt_f32_bf16(const Frame& F, const float* src, bf16* dst, size_t n8) {
    for (size_t i0 = F.gt; i0 < n8; i0 += (size_t)4 * F.NGT) {
        f32x4 a[4], b[4];
#pragma unroll
        for (int u = 0; u < 4; ++u) { const size_t i = i0 + (size_t)u * F.NGT; if (i < n8) { a[u] = __builtin_nontemporal_load((const f32x4*)(src + i * 8)); b[u] = __builtin_nontemporal_load((const f32x4*)(src + i * 8 + 4)); } }
#pragma unroll
        for (int u = 0; u < 4; ++u) { const size_t i = i0 + (size_t)u * F.NGT; if (i < n8) { v4u o; o.x = cvtpk(a[u][0], a[u][1]); o.y = cvtpk(a[u][2], a[u][3]); o.z = cvtpk(b[u][0], b[u][1]); o.w = cvtpk(b[u][2], b[u][3]); *(v4u*)(dst + i * 8) = o; } }
    }
}
__device__ __forceinline__ void row_load(const float* xrow, int lane, f32x4 (&v)[8]) {
#pragma unroll
    for (int j = 0; j < 4; ++j) { v[2 * j] = *(const f32x4*)(xrow + lane * 8 + 512 * j); v[2 * j + 1] = *(const f32x4*)(xrow + lane * 8 + 512 * j + 4); }
}
__device__ __forceinline__ void row_load_nt(const float* xrow, int lane, f32x4 (&v)[8]) {
#pragma unroll
    for (int j = 0; j < 4; ++j) { v[2 * j] = __builtin_nontemporal_load((const f32x4*)(xrow + lane * 8 + 512 * j)); v[2 * j + 1] = __builtin_nontemporal_load((const f32x4*)(xrow + lane * 8 + 512 * j + 4)); }
}
__device__ __forceinline__ float row_rstd(const f32x4 (&v)[8]) {
    float s = 0.f;
#pragma unroll
    for (int j = 0; j < 8; ++j) s += (v[j][0] * v[j][0] + v[j][1] * v[j][1]) + (v[j][2] * v[j][2] + v[j][3] * v[j][3]);
    return 1.f / sqrtf(wave_sum(s) * (1.f / DM) + RMS_EPS);
}
__device__ __forceinline__ void row_store_norm(const f32x4 (&v)[8], float rstd, const float* w, bf16* orow, int lane) {
#pragma unroll
    for (int j = 0; j < 4; ++j) { const f32x4 w0 = *(const f32x4*)(w + lane * 8 + 512 * j), w1 = *(const f32x4*)(w + lane * 8 + 512 * j + 4);
        const f32x4 a = v[2 * j] * rstd * w0, b = v[2 * j + 1] * rstd * w1;
        v4u o; o.x = cvtpk(a[0], a[1]); o.y = cvtpk(a[2], a[3]); o.z = cvtpk(b[0], b[1]); o.w = cvtpk(b[2], b[3]);
        *(v4u*)(orow + lane * 8 + 512 * j) = o; }
}
__device__ __forceinline__ void row_store_norm8(const f32x4 (&v)[8], float rstd, const float* w, unsigned char* orow, int lane) {
#pragma unroll
    for (int j = 0; j < 4; ++j) { const f32x4 w0 = *(const f32x4*)(w + lane * 8 + 512 * j), w1 = *(const f32x4*)(w + lane * 8 + 512 * j + 4);
        *(v2u*)(orow + lane * 8 + 512 * j) = pack8_fp8(v[2 * j] * rstd * w0, v[2 * j + 1] * rstd * w1); }
}
template <bool NT = false>
__device__ __forceinline__ void norm_phase(const Frame& F, const float* X, const float* w, bf16* XN, unsigned char* XN8 = nullptr) {
    int m = F.gw; if (m >= SEQ) return;
    f32x4 va[8], vb[8];
    if (NT) row_load_nt(X + (size_t)m * DM, F.lane, va); else row_load(X + (size_t)m * DM, F.lane, va);
    for (;;) {
        const int m1 = m + F.NGW; const bool h1 = m1 < SEQ;
        if (h1) { if (NT) row_load_nt(X + (size_t)m1 * DM, F.lane, vb); else row_load(X + (size_t)m1 * DM, F.lane, vb); }
        { const float rstd = row_rstd(va); row_store_norm(va, rstd, w, XN + (size_t)m * DM, F.lane); if (XN8) row_store_norm8(va, rstd, w, XN8 + (size_t)m * DM, F.lane); }
        if (!h1) break;
        const int m2 = m1 + F.NGW; const bool h2 = m2 < SEQ;
        if (h2) { if (NT) row_load_nt(X + (size_t)m2 * DM, F.lane, va); else row_load(X + (size_t)m2 * DM, F.lane, va); }
        { const float rstd = row_rstd(vb); row_store_norm(vb, rstd, w, XN + (size_t)m1 * DM, F.lane); if (XN8) row_store_norm8(vb, rstd, w, XN8 + (size_t)m1 * DM, F.lane); }
        if (!h2) break;
        m = m2;
    }
}
__device__ __forceinline__ void final_norm_phase(const Frame& F, const float* X, const float* w, float* out) {
    for (int m = F.gw; m < SEQ; m += F.NGW) { f32x4 v[8]; row_load(X + (size_t)m * DM, F.lane, v); const float rstd = row_rstd(v);
#pragma unroll
        for (int j = 0; j < 4; ++j) { const f32x4 w0 = *(const f32x4*)(w + F.lane * 8 + 512 * j), w1 = *(const f32x4*)(w + F.lane * 8 + 512 * j + 4);
            *(f32x4*)(out + (size_t)m * DM + F.lane * 8 + 512 * j) = v[2 * j] * rstd * w0; *(f32x4*)(out + (size_t)m * DM + F.lane * 8 + 512 * j + 4) = v[2 * j + 1] * rstd * w1; } }
}
__device__ __forceinline__ void kvnorm_pack(const Frame& F, const float* wkvf, f32x4* WFP) {
    for (int u = F.gt; u < 8192; u += F.NGT) { const int ln = u & 63, q = (u >> 6) & 3, je = u >> 8, k = ln * 8 + 512 * (je >> 3) + (je & 7);
        WFP[u] = *(const f32x4*)(wkvf + (size_t)k * 4112 + 4096 + 4 * q); }
}
__device__ __forceinline__ void kvnorm_stage(const Frame& F, const f32x4* WFP) {
    LAS f32x4* wl = (LAS f32x4*)F.lds;
#pragma unroll
    for (int i = 0; i < 16; ++i) { const int u = F.tid + i * NWAVES_ * 64; wl[u] = WFP[u]; }
    __syncthreads();
}
__device__ __forceinline__ void kvnorm_rows(const Frame& F, const float* X, const float* kvw, const float* bw, const float* b_f, unsigned char* XN, unsigned char* XN2, float* LOGF) {
    LAS f32x4* wl = (LAS f32x4*)F.lds;
    for (int m = F.gw; m < SEQ; m += F.NGW) {
        f32x4 v[8]; row_load(X + (size_t)m * DM, F.lane, v); const float rstd = row_rstd(v);
        row_store_norm8(v, rstd, bw, XN2 + (size_t)m * DM, F.lane);
        row_store_norm8(v, rstd, kvw, XN + (size_t)m * DM, F.lane);
        f32x4 acc[4];
#pragma unroll
        for (int q = 0; q < 4; ++q) acc[q] = (f32x4){0.f, 0.f, 0.f, 0.f};
#pragma unroll
        for (int j = 0; j < 4; ++j) { const f32x4 k0 = *(const f32x4*)(kvw + F.lane * 8 + 512 * j), k1 = *(const f32x4*)(kvw + F.lane * 8 + 512 * j + 4);
#pragma unroll
            for (int e = 0; e < 8; ++e) { const float xv = v[2 * j + (e >> 2)][e & 3] * rstd * (e < 4 ? k0[e & 3] : k1[e & 3]);
                if ((e & 3) == 0) asm volatile("" ::: "memory");
#pragma unroll
                for (int q = 0; q < 4; ++q) acc[q] += wl[((j * 8 + e) * 4 + q) * 64 + F.lane] * xv; } }
        float mine = 0.f;
#pragma unroll
        for (int f = 0; f < 16; ++f) { const float s = wave_sum(acc[f >> 2][f & 3]); if (F.lane == f) mine = s; }
        if (F.lane < 16) { const float z = mine + b_f[F.lane]; LOGF[(size_t)F.lane * SEQ + m] = fminf(z, 0.f) - log1pf(__expf(-fabsf(z))); }
    }
}
__device__ __forceinline__ void cumsum_unit(const Frame& F, int f, const float* LOGF, float* NB) {
    LAS float* wt = (LAS float*)F.lds;
    float loc[16]; float s = 0.f;
    { const f32x4* lp = (const f32x4*)(LOGF + (size_t)f * SEQ + F.tid * 16);
      const f32x4 l0 = lp[0], l1 = lp[1], l2 = lp[2], l3 = lp[3];
#pragma unroll
      for (int i = 0; i < 16; ++i) { s += (i < 4 ? l0[i & 3] : i < 8 ? l1[i & 3] : i < 12 ? l2[i & 3] : l3[i & 3]); loc[i] = s; } }
    float incl = s;
#pragma unroll
    for (int o = 1; o < 64; o <<= 1) { const float n = __shfl_up(incl, o); if (F.lane >= o) incl += n; }
    if (F.lane == 63) wt[F.wave] = incl;
    __syncthreads();
    float pre = incl - s;
    for (int w = 0; w < F.wave; ++w) pre += wt[w];
    const float inv = -1.f / fox::SCALE;
#pragma unroll
    for (int i = 0; i < 4; ++i) *(f32x4*)(NB + (size_t)f * SEQ + F.tid * 16 + 4 * i) = (f32x4){(pre + loc[4 * i]) * inv, (pre + loc[4 * i + 1]) * inv, (pre + loc[4 * i + 2]) * inv, (pre + loc[4 * i + 3]) * inv};
    __syncthreads();
}
__device__ __forceinline__ void conv_phase(const Frame& F, const bf16* XBC, const float* cw, const float* cb, bf16* XBCC) {
    constexpr int NCG = CONVD / 8, SEGT = 16, NSEG = SEQ / SEGT;
    for (int id = F.gt; id < NCG * NSEG; id += F.NGT) {
        const int cg_ = id % NCG, seg = id / NCG, c0 = cg_ * 8, t0 = seg * SEGT;
        float w[4][8], b[8];
#pragma unroll
        for (int k = 0; k < 4; ++k) { const f32x4 a = *(const f32x4*)(cw + k * CONVD + c0), bq = *(const f32x4*)(cw + k * CONVD + c0 + 4);
#pragma unroll
            for (int e = 0; e < 4; ++e) { w[k][e] = a[e]; w[k][4 + e] = bq[e]; } }
        { const f32x4 a = *(const f32x4*)(cb + c0), bq = *(const f32x4*)(cb + c0 + 4);
#pragma unroll
          for (int e = 0; e < 4; ++e) { b[e] = a[e]; b[4 + e] = bq[e]; } }
        v4u raw[SEGT + 3];
#pragma unroll
        for (int i = 0; i < SEGT + 3; ++i) { const int t = t0 - 3 + i; raw[i] = (t >= 0) ? *(const v4u*)(XBC + (size_t)t * CONVD + c0) : (v4u){0u, 0u, 0u, 0u}; }
#pragma unroll
        for (int i = 0; i < SEGT; ++i) { float y[8];
#pragma unroll
            for (int e = 0; e < 8; ++e) { float s = b[e];
#pragma unroll
                for (int k = 0; k < 4; ++k) { const unsigned u = raw[i + k][e >> 1]; s += w[k][e] * ((e & 1) ? bfhi(u) : bflo(u)); }
                y[e] = siluf_(s); }
            v4u o; o.x = cvtpk(y[0], y[1]); o.y = cvtpk(y[2], y[3]); o.z = cvtpk(y[4], y[5]); o.w = cvtpk(y[6], y[7]);
            *(v4u*)(XBCC + (size_t)(t0 + i) * CONVD + c0) = o; }
    }
}
__device__ __forceinline__ void conv_unit(const Frame& F, int c, int g, const bf16* XBC, const float* cw, const float* cb, bf16* XBCC) {
    constexpr int SEGT = 16;
    for (int id = F.tid; id < 96 * (CHK / SEGT); id += NWAVES_ * 64) {
        const int cgl = id % 96, seg = id / 96, t0 = c * CHK + seg * SEGT;
        const int c0 = cgl < 64 ? g * 512 + cgl * 8 : (cgl < 80 ? 4096 + g * 128 + (cgl - 64) * 8 : 5120 + g * 128 + (cgl - 80) * 8);
        float w[4][8], b[8];
#pragma unroll
        for (int k = 0; k < 4; ++k) { const f32x4 a = *(const f32x4*)(cw + k * CONVD + c0), bq = *(const f32x4*)(cw + k * CONVD + c0 + 4);
#pragma unroll
            for (int e = 0; e < 4; ++e) { w[k][e] = a[e]; w[k][4 + e] = bq[e]; } }
        { const f32x4 a = *(const f32x4*)(cb + c0), bq = *(const f32x4*)(cb + c0 + 4);
#pragma unroll
          for (int e = 0; e < 4; ++e) { b[e] = a[e]; b[4 + e] = bq[e]; } }
        v4u raw[SEGT + 3];
#pragma unroll
        for (int i = 0; i < SEGT + 3; ++i) { const int t = t0 - 3 + i; raw[i] = (t >= 0) ? *(const v4u*)(XBC + (size_t)t * CONVD + c0) : (v4u){0u, 0u, 0u, 0u}; }
#pragma unroll
        for (int i = 0; i < SEGT; ++i) { float y[8];
#pragma unroll
            for (int e = 0; e < 8; ++e) { float s_ = b[e];
#pragma unroll
                for (int k = 0; k < 4; ++k) { const unsigned u = raw[i + k][e >> 1]; s_ += w[k][e] * ((e & 1) ? bfhi(u) : bflo(u)); }
                y[e] = siluf_(s_); }
            v4u o; o.x = cvtpk(y[0], y[1]); o.y = cvtpk(y[2], y[3]); o.z = cvtpk(y[4], y[5]); o.w = cvtpk(y[6], y[7]);
            *(v4u*)(XBCC + (size_t)(t0 + i) * CONVD + c0) = o; }
    }
}
__device__ __forceinline__ void acum8_unit(const Frame& F, int c, int g, float* DT, const float* dtb, const float* A_log, float* ACL) {
    LAS float* tot = (LAS float*)F.lds;
    const int h8 = F.tid & 7, seg = F.tid >> 3, h = g * 8 + h8; const float a = -__expf(A_log[h]) * LOG2E;
    float loc[4]; float s = 0.f; const int tb = c * CHK + seg * 4; const float bias = dtb[h];
#pragma unroll
    for (int i = 0; i < 4; ++i) { const float xr = DT[(size_t)(tb + i) * 64 + h] + bias; const float d = fmaxf(xr, 0.f) + log1pf(__expf(-fabsf(xr))); DT[(size_t)(tb + i) * 64 + h] = d; s += d * a; loc[i] = s; }
    tot[seg * 8 + h8] = s;
    __syncthreads();
    float pre = 0.f;
    for (int q = 0; q < seg; ++q) pre += tot[q * 8 + h8];
#pragma unroll
    for (int i = 0; i < 4; ++i) ACL[(size_t)(tb + i) * 64 + h] = pre + loc[i];
    __syncthreads();
}
__device__ __forceinline__ void acum_unit(const Frame& F, int c, float* DT, const float* dtb, const float* A_log, float* ACL) {
    LAS float* tot = (LAS float*)F.lds;
    const int h = F.tid & 63, seg = F.tid >> 6; const float a = -__expf(A_log[h]) * LOG2E;
    float loc[32]; float s = 0.f; const int tb = c * CHK + seg * 32; const float bias = dtb[h];
#pragma unroll
    for (int i = 0; i < 32; ++i) { const float xr = DT[(size_t)(tb + i) * 64 + h] + bias; const float d = fmaxf(xr, 0.f) + log1pf(__expf(-fabsf(xr))); DT[(size_t)(tb + i) * 64 + h] = d; s += d * a; loc[i] = s; }
    tot[seg * 64 + h] = s;
    __syncthreads();
    float pre = 0.f;
    for (int q = 0; q < seg; ++q) pre += tot[q * 64 + h];
#pragma unroll
    for (int i = 0; i < 32; ++i) ACL[(size_t)(tb + i) * 64 + h] = pre + loc[i];
    __syncthreads();
}
__device__ __forceinline__ void gnorm_load(const bf16* Y, const bf16* Z, int it0, int lane, v4u (&yr)[4], v4u (&zr)[4]) {
#pragma unroll
    for (int u = 0; u < 4; ++u) { const int it = it0 + u; const size_t off = (size_t)(it >> 3) * DI + (it & 7) * 512 + lane * 8; yr[u] = *(const v4u*)(Y + off); zr[u] = *(const v4u*)(Z + off); }
}
__device__ __forceinline__ void gnorm_emit(bf16* Y, const float* gw_, int it0, int lane, const v4u (&yr)[4], const v4u (&zr)[4], const bool dry) {
#pragma unroll
    for (int u = 0; u < 4; ++u) { const int it = it0 + u, g = it & 7; const size_t off = (size_t)(it >> 3) * DI + g * 512 + lane * 8;
        float y[8] = {bflo(yr[u].x), bfhi(yr[u].x), bflo(yr[u].y), bfhi(yr[u].y), bflo(yr[u].z), bfhi(yr[u].z), bflo(yr[u].w), bfhi(yr[u].w)};
        const float z[8] = {bflo(zr[u].x), bfhi(zr[u].x), bflo(zr[u].y), bfhi(zr[u].y), bflo(zr[u].z), bfhi(zr[u].z), bflo(zr[u].w), bfhi(zr[u].w)};
        float s = 0.f;
#pragma unroll
        for (int e = 0; e < 8; ++e) { y[e] = y[e] * siluf_(z[e]); s += y[e] * y[e]; }
        const float r = 1.f / sqrtf(wave_sum(s) * (1.f / 512.f) + GN_EPS);
        const f32x4 w0 = *(const f32x4*)(gw_ + g * 512 + lane * 8), w1 = *(const f32x4*)(gw_ + g * 512 + lane * 8 + 4);
        v4u o; o.x = cvtpk(y[0] * r * w0[0], y[1] * r * w0[1]); o.y = cvtpk(y[2] * r * w0[2], y[3] * r * w0[3]); o.z = cvtpk(y[4] * r * w1[0], y[5] * r * w1[1]); o.w = cvtpk(y[6] * r * w1[2], y[7] * r * w1[3]);
        if (!dry) *(v4u*)(Y + off) = o; }
}
__device__ __forceinline__ void gnorm_phase(const Frame& F, bf16* Y, const bf16* Z, const float* gw_, const bool dry) {
    const int N = SEQ * NG, st = F.NGW * 4;
    int it0 = F.gw * 4; if (it0 >= N) return;
    v4u ya[4], za[4], yb[4], zb[4];
    gnorm_load(Y, Z, it0, F.lane, ya, za);
    for (;;) {
        const int it1 = it0 + st; const bool h1 = it1 < N;
        if (h1) gnorm_load(Y, Z, it1, F.lane, yb, zb);
        gnorm_emit(Y, gw_, it0, F.lane, ya, za, dry);
        if (!h1) break;
        const int it2 = it1 + st; const bool h2 = it2 < N;
        if (h2) gnorm_load(Y, Z, it2, F.lane, ya, za);
        gnorm_emit(Y, gw_, it1, F.lane, yb, zb, dry);
        if (!h2) break;
        it0 = it2;
    }
}
__device__ __forceinline__ void dt_unit(LAS unsigned char* ldsu, int tt, const bf16* XN, const bf16* Wdt, float* DT, const int tid) {
    const int wid = __builtin_amdgcn_readfirstlane(tid >> 6), lane = tid & 63, r32 = lane & 31, hi = lane >> 5, t0 = tt * 32;
    f32x16 acc0 = f32x16{}, acc1 = f32x16{};
    const bf16* ap = XN + (size_t)(t0 + r32) * DM + 256 * wid + 8 * hi;
    const bf16* bp = Wdt + (size_t)r32 * DM + 256 * wid + 8 * hi;
#pragma unroll 4
    for (int ks = 0; ks < 16; ++ks) { const bf16x8 a = *(const bf16x8*)(ap + 16 * ks), b0 = *(const bf16x8*)(bp + 16 * ks), b1 = *(const bf16x8*)(bp + 32 * DM + 16 * ks);
        acc0 = __builtin_amdgcn_mfma_f32_32x32x16_bf16(a, b0, acc0, 0, 0, 0); acc1 = __builtin_amdgcn_mfma_f32_32x32x16_bf16(a, b1, acc1, 0, 0, 0); }
    LAS float* red = (LAS float*)ldsu;
#pragma unroll
    for (int r = 0; r < 16; ++r) { const int row = wid * 32 + fox::crow(r, hi); red[row * 64 + r32] = acc0[r]; red[row * 64 + 32 + r32] = acc1[r]; }
    __syncthreads();
    { const int token = tid >> 4, c4 = (tid & 15) * 4; f32x4 s = {0.f, 0.f, 0.f, 0.f};
#pragma unroll
      for (int w = 0; w < 8; ++w) s += *(const LAS f32x4*)(red + (w * 32 + token) * 64 + c4);
      *(f32x4*)(DT + (size_t)(t0 + token) * 64 + c4) = s; }
    __syncthreads();
}

__device__ __forceinline__ void qknorm_tile(const Frame& F, const bf16* T, int pm, int pn, unsigned* NORM  ) {
    float mx = 0.f;
#pragma unroll 4
    for (int i = 0; i < 16; ++i) { const int row = pm * 256 + F.wave * 32 + 2 * i + (F.lane >> 5);
        const v4u a = *(const v4u*)(T + (size_t)row * DM + pn * 256 + (F.lane & 31) * 8);
        float s = bflo(a.x) * bflo(a.x) + bfhi(a.x) * bfhi(a.x) + bflo(a.y) * bflo(a.y) + bfhi(a.y) * bfhi(a.y) + bflo(a.z) * bflo(a.z) + bfhi(a.z) * bfhi(a.z) + bflo(a.w) * bflo(a.w) + bfhi(a.w) * bfhi(a.w);
        s += DPP_F(s, 0xB1); s += DPP_F(s, 0x4E); s += DPP_F(s, 0x141); s += DPP_F(s, 0x140);
        mx = fmaxf(mx, s); }
    const float other = __shfl_xor(mx, 32); mx = fmaxf(mx, other);
    if (F.lane == 0 || F.lane == 16) atomicMax(NORM + 2 * pn + (F.lane >> 4), __float_as_uint(mx));
}
__device__ __forceinline__ void qknorm_phase(const Frame& F, const bf16* Q, const bf16* K, unsigned* NORM) {
    float mq[4] = {0.f, 0.f, 0.f, 0.f}, mk[4] = {0.f, 0.f, 0.f, 0.f};
    for (int m = F.gw; m < 2 * SEQ; m += F.NGW) { const bool isk = m >= SEQ; const bf16* row = isk ? K + (size_t)(m - SEQ) * DM : Q + (size_t)m * DM;
#pragma unroll
        for (int j = 0; j < 4; ++j) { const v4u a = *(const v4u*)(row + F.lane * 8 + 512 * j);
            float s = bflo(a.x) * bflo(a.x) + bfhi(a.x) * bfhi(a.x) + bflo(a.y) * bflo(a.y) + bfhi(a.y) * bfhi(a.y) + bflo(a.z) * bflo(a.z) + bfhi(a.z) * bfhi(a.z) + bflo(a.w) * bflo(a.w) + bfhi(a.w) * bfhi(a.w);
            s += DPP_F(s, 0xB1); s += DPP_F(s, 0x4E); s += DPP_F(s, 0x141); s += DPP_F(s, 0x140);
            if (isk) mk[j] = fmaxf(mk[j], s); else mq[j] = fmaxf(mq[j], s); } }
    LAS float* red = (LAS float*)F.lds;
    if ((F.lane & 15) == 0) {
#pragma unroll
        for (int j = 0; j < 4; ++j) { red[F.wave * 32 + 4 * j + (F.lane >> 4)] = mq[j]; red[F.wave * 32 + 16 + 4 * j + (F.lane >> 4)] = mk[j]; } }
    __syncthreads();
    if (F.tid < 32) { float v = 0.f;
#pragma unroll
        for (int w = 0; w < 8; ++w) v = fmaxf(v, red[w * 32 + F.tid]);
        atomicMax(NORM + F.tid, __float_as_uint(v)); }
    __syncthreads();
}

__device__ __forceinline__ void attn_combine_phase(const Frame& F, bf16* O, const bf16* OP, const float* ML) {
    constexpr float C2 = 1.4426950408889634f * fox::SCALE; constexpr int N = (SEQ / 2) * 4;
    for (int it0 = F.gw; it0 < N; it0 += 4 * F.NGW) {
        f32x2_t a[4], b[4]; v4u p[4], q[4];
#pragma unroll
        for (int u = 0; u < 4; ++u) { const int it = it0 + u * F.NGW; if (it < N) { const int t = SEQ / 2 + (it >> 2), j = it & 3, hd = 4 * j + (F.lane >> 4); const size_t off = (size_t)t * DM + F.lane * 8 + 512 * j;
            a[u] = *(const f32x2_t*)(ML + (size_t)t * 32 + hd * 2); b[u] = *(const f32x2_t*)(ML + (size_t)SEQ * 32 + (size_t)t * 32 + hd * 2);
            p[u] = __builtin_nontemporal_load((const v4u*)(OP + off)); q[u] = __builtin_nontemporal_load((const v4u*)(OP + (size_t)SEQ * DM + off)); } }
#pragma unroll
        for (int u = 0; u < 4; ++u) { const int it = it0 + u * F.NGW; if (it < N) { const int t = SEQ / 2 + (it >> 2), j = it & 3; const size_t off = (size_t)t * DM + F.lane * 8 + 512 * j;
            const float mm = fmaxf(a[u].x, b[u].x); float w0 = a[u].y * __builtin_amdgcn_exp2f((a[u].x - mm) * C2), w1 = b[u].y * __builtin_amdgcn_exp2f((b[u].x - mm) * C2);
            const float inv = 1.f / (w0 + w1); w0 *= inv; w1 *= inv; v4u o;
            o.x = cvtpk(w0 * bflo(p[u].x) + w1 * bflo(q[u].x), w0 * bfhi(p[u].x) + w1 * bfhi(q[u].x)); o.y = cvtpk(w0 * bflo(p[u].y) + w1 * bflo(q[u].y), w0 * bfhi(p[u].y) + w1 * bfhi(q[u].y));
            o.z = cvtpk(w0 * bflo(p[u].z) + w1 * bflo(q[u].z), w0 * bfhi(p[u].z) + w1 * bfhi(q[u].z)); o.w = cvtpk(w0 * bflo(p[u].w) + w1 * bflo(q[u].w), w0 * bfhi(p[u].w) + w1 * bfhi(q[u].w));
            *(v4u*)(O + off) = o; } }
    }
}
namespace ssd {
typedef short v4i16_t __attribute__((ext_vector_type(4)));
using fox::crow;
__device__ __forceinline__ s16x4 vtr(const LAS char* p) { return __builtin_bit_cast(s16x4, __builtin_amdgcn_ds_read_tr16_b64_v4i16((LAS v4i16_t*)p)); }
__device__ __forceinline__ bf16x8 vfrag(const LAS char* tile, int vrb, int d0, int ks) {
    const s16x4 l = vtr(tile + vrb + d0 * 512 + ks * 4096), h = vtr(tile + vrb + d0 * 512 + ks * 4096 + 2048);
    return (bf16x8){l[0], l[1], l[2], l[3], h[0], h[1], h[2], h[3]};
}
__device__ __forceinline__ void s1_unit(LAS unsigned char* ldsu, int c, int g, const bf16* XBCC, const float* DT, const float* ACL, float* SLOC, const int tid) {
    LAS char* lds = (LAS char*)ldsu;
    const int wid = __builtin_amdgcn_readfirstlane(tid >> 6), lane = tid & 63, r32 = lane & 31, hi = lane >> 5;
    const int sr = tid >> 4, sc = (tid & 15) * 8;
    LAS char* Bv = lds; LAS char* Xv = lds + 16384;
    const int vrb = fox::v_rd_base(lane), hd = g * 8 + wid, tlast = c * CHK + CHK - 1;
    f32x16 acc[2][4];
#pragma unroll
    for (int i = 0; i < 2; ++i)
#pragma unroll
        for (int d = 0; d < 4; ++d) acc[i][d] = f32x16{};
    float al[4];
#pragma unroll
    for (int vt = 0; vt < 4; ++vt) al[vt] = ACL[(unsigned)(tlast * 64 + g * 8 + 2 * vt + (sc >> 6))];
#pragma unroll 1
    for (int lt = 0; lt < 4; ++lt) {
        const int t0 = c * CHK + lt * 64;
        v4u braw[2], xraw[2][4]; float wv[2][4];
#pragma unroll
        for (int hh = 0; hh < 2; ++hh) { const unsigned trow_ = (unsigned)(t0 + sr + 32 * hh), rb = trow_ * CONVD;
            braw[hh] = *(const v4u*)(XBCC + (rb + (unsigned)(4096 + g * 128 + sc)));
#pragma unroll
            for (int vt = 0; vt < 4; ++vt) { const int col = vt * 128 + sc; const unsigned ho = trow_ * 64 + (unsigned)(g * 8 + (col >> 6));
                wv[hh][vt] = ACL[ho]; xraw[hh][vt] = *(const v4u*)(XBCC + (rb + (unsigned)(g * 512 + col))); } }
#pragma unroll
        for (int hh = 0; hh < 2; ++hh) { const unsigned trow_ = (unsigned)(t0 + sr + 32 * hh);
#pragma unroll
            for (int vt = 0; vt < 4; ++vt) { const int col = vt * 128 + sc; const unsigned ho = trow_ * 64 + (unsigned)(g * 8 + (col >> 6)); wv[hh][vt] = __builtin_amdgcn_exp2f(al[vt] - wv[hh][vt]) * DT[ho]; } }
#pragma unroll
        for (int hh = 0; hh < 2; ++hh) { const int row = sr + 32 * hh;
            *(LAS v4u*)(Bv + fox::v_st(row, sc)) = braw[hh];
#pragma unroll
            for (int vt = 0; vt < 4; ++vt) { const float w = wv[hh][vt]; const v4u xr = xraw[hh][vt];
                v4u o; o.x = cvtpk(bflo(xr.x) * w, bfhi(xr.x) * w); o.y = cvtpk(bflo(xr.y) * w, bfhi(xr.y) * w); o.z = cvtpk(bflo(xr.z) * w, bfhi(xr.z) * w); o.w = cvtpk(bflo(xr.w) * w, bfhi(xr.w) * w);
                *(LAS v4u*)(Xv + vt * 16384 + fox::v_st(row, sc)) = o; } }
        __syncthreads();
        const LAS char* xt = Xv + (wid >> 1) * 16384;
#pragma unroll 1
        for (int ks = 0; ks < 4; ++ks) { const bf16x8 xf0 = vfrag(xt, vrb, 2 * (wid & 1), ks), xf1 = vfrag(xt, vrb, 2 * (wid & 1) + 1, ks);
#pragma unroll
            for (int d = 0; d < 4; ++d) { const bf16x8 bfr = vfrag(Bv, vrb, d, ks);
                acc[0][d] = __builtin_amdgcn_mfma_f32_32x32x16_bf16(xf0, bfr, acc[0][d], 0, 0, 0);
                acc[1][d] = __builtin_amdgcn_mfma_f32_32x32x16_bf16(xf1, bfr, acc[1][d], 0, 0, 0); } }
        __syncthreads();
    }
    int lane2 = lane; asm volatile("" : "+v"(lane2));
    bf16* out = (bf16*)SLOC + ((size_t)c * NHS + hd) * (HP * NST) + (lane2 >> 5) * 4 * NST + (lane2 & 31);
#pragma unroll
    for (int i = 0; i < 2; ++i)
#pragma unroll
        for (int d = 0; d < 4; ++d)
#pragma unroll
            for (int r = 0; r < 16; ++r) out[(32 * i + crow(r, 0)) * NST + 32 * d] = (bf16)(cvtpk(acc[i][d][r], 0.f) & 0xffffu);
}
__device__ __forceinline__ void s2_phase(const Frame& F, const float* SLOC, const float* ACL, bf16* SIN) {
    constexpr int PER = NHS * HP * NST;
    for (int e4 = F.gt; e4 < PER / 4; e4 += F.NGT) { const int e = e4 * 4, hd = e / (HP * NST);
        v2u lb[NCH]; float dec[NCH];
#pragma unroll
        for (int c = 0; c < NCH; ++c) { lb[c] = *(const v2u*)((const bf16*)SLOC + (size_t)c * PER + e); dec[c] = ACL[(unsigned)((c * CHK + CHK - 1) * 64 + hd)]; }
        f32x4 st = {0.f, 0.f, 0.f, 0.f};
#pragma unroll
        for (int c = 0; c < NCH; ++c) {
            v2u o; o.x = cvtpk(st[0], st[1]); o.y = cvtpk(st[2], st[3]); *(v2u*)(SIN + (size_t)c * PER + e) = o;
            const f32x4 loc = {bflo(lb[c].x), bfhi(lb[c].x), bflo(lb[c].y), bfhi(lb[c].y)};
            st = st * __builtin_amdgcn_exp2f(dec[c]) + loc; } }
}
__device__ __forceinline__ void s3_unit(LAS unsigned char* ldsu, int c, int hd, const bf16* XBCC, const float* DT, const float* ACL, const bf16* SIN, const float* Dskip, bf16* Y, const int tid) {
    LAS char* lds = (LAS char*)ldsu;
    const int wid = __builtin_amdgcn_readfirstlane(tid >> 6), lane = tid & 63, r32 = lane & 31, hi = lane >> 5, g = hd >> 3;
    const int sr = tid >> 4, sc = (tid & 15) * 8;
    LAS char* Kt = lds; LAS char* Vt = lds + 16384;
    LAS float* acs = (LAS float*)(lds + 32768); LAS float* dts = acs + 64; LAS float* wsc = acs + 128 + wid * 32;
    const int vrb = fox::v_rd_base(lane), t0 = c * CHK, l0 = 32 * wid, trow = t0 + l0 + r32;
    bf16x8 qr[8];
#pragma unroll
    for (int d0 = 0; d0 < 8; ++d0) qr[d0] = *(const bf16x8*)(XBCC + (size_t)trow * CONVD + 5120 + g * 128 + d0 * 16 + hi * 8);
    const float acl = ACL[(size_t)trow * 64 + hd];
    f32x16 o[2]; o[0] = f32x16{}; o[1] = f32x16{};
    const bf16* sp = SIN + ((size_t)c * NHS + hd) * (HP * NST);
#pragma unroll
    for (int i = 0; i < 2; ++i)
#pragma unroll
        for (int ks = 0; ks < 8; ++ks) { const bf16x8 sf = *(const bf16x8*)(sp + (32 * i + r32) * NST + 16 * ks + 8 * hi); o[i] = __builtin_amdgcn_mfma_f32_32x32x16_bf16(qr[ks], sf, o[i], 0, 0, 0); }
    if (hi == 0) wsc[r32] = __builtin_amdgcn_exp2f(acl);
    LDS_WAIT();
#pragma unroll
    for (int i = 0; i < 2; ++i)
#pragma unroll
        for (int r = 0; r < 16; ++r) o[i][r] *= wsc[crow(r, hi)];
    for (int j = 0; j < 4; ++j) {
        const int s0 = t0 + 64 * j;
#pragma unroll
        for (int hh = 0; hh < 2; ++hh) { const int row = sr + 32 * hh; const size_t rb = (size_t)(s0 + row) * CONVD;
            *(LAS v4u*)(Kt + KSWZ(row, sc * 2)) = *(const v4u*)(XBCC + rb + 4096 + g * 128 + sc);
            if ((tid & 15) < 8) *(LAS v4u*)(Vt + fox::v_st(row, sc)) = *(const v4u*)(XBCC + rb + hd * 64 + sc); }
        if (tid < 64) { acs[tid] = ACL[(size_t)(s0 + tid) * 64 + hd]; dts[tid] = DT[(size_t)(s0 + tid) * 64 + hd]; }
        __syncthreads();
        if (j <= (wid >> 1)) {
            f32x16 p0 = f32x16{}, p1 = f32x16{};
#pragma unroll
            for (int d0 = 0; d0 < 8; ++d0) { const LAS char* a = Kt + KSWZ(r32, ((d0 & 3) * 16 + hi * 8) * 2) + (d0 >> 2) * 128;
                const bf16x8 b0 = *(const LAS bf16x8*)a, b1 = *(const LAS bf16x8*)(a + 32 * 256);
                p0 = __builtin_amdgcn_mfma_f32_32x32x16_bf16(b0, qr[d0], p0, 0, 0, 0);
                p1 = __builtin_amdgcn_mfma_f32_32x32x16_bf16(b1, qr[d0], p1, 0, 0, 0); }
            const int lrel = l0 + r32 - 64 * j;
#pragma unroll
            for (int jj = 0; jj < 4; ++jj) { const f32x4 a0 = *(const LAS f32x4*)(acs + 8 * jj + 4 * hi), a1 = *(const LAS f32x4*)(acs + 32 + 8 * jj + 4 * hi);
                const f32x4 e0 = *(const LAS f32x4*)(dts + 8 * jj + 4 * hi), e1 = *(const LAS f32x4*)(dts + 32 + 8 * jj + 4 * hi);
#pragma unroll
                for (int i = 0; i < 4; ++i) { const int r = 4 * jj + i, srel = 8 * jj + 4 * hi + i;
                    const float f0 = p0[r] * __builtin_amdgcn_exp2f(acl - a0[i]) * e0[i], f1 = p1[r] * __builtin_amdgcn_exp2f(acl - a1[i]) * e1[i];
                    p0[r] = (srel <= lrel) ? f0 : 0.f; p1[r] = (srel + 32 <= lrel) ? f1 : 0.f; } }
            bf16x8 pa0, pa1, pa2, pa3;
            FOX_PK4(p0, 0, pa0); FOX_PK4(p0, 8, pa1); FOX_PK4(p1, 0, pa2); FOX_PK4(p1, 8, pa3);
#pragma unroll
            for (int i = 0; i < 2; ++i) {
                o[i] = __builtin_amdgcn_mfma_f32_32x32x16_bf16(pa0, vfrag(Vt, vrb, i, 0), o[i], 0, 0, 0);
                o[i] = __builtin_amdgcn_mfma_f32_32x32x16_bf16(pa1, vfrag(Vt, vrb, i, 1), o[i], 0, 0, 0);
                o[i] = __builtin_amdgcn_mfma_f32_32x32x16_bf16(pa2, vfrag(Vt, vrb, i, 2), o[i], 0, 0, 0);
                o[i] = __builtin_amdgcn_mfma_f32_32x32x16_bf16(pa3, vfrag(Vt, vrb, i, 3), o[i], 0, 0, 0); }
        }
        __syncthreads();
    }
    const float Dh = Dskip[hd];
#pragma unroll
    for (int r = 0; r < 16; ++r) { const size_t row = (size_t)(t0 + l0 + crow(r, hi));
#pragma unroll
        for (int i = 0; i < 2; ++i) { const int col = hd * 64 + 32 * i + r32;
            const float xv = __builtin_bit_cast(float, (unsigned)XBCC[row * CONVD + col] << 16);
            const float v = o[i][r] + Dh * xv, vn = __shfl_xor(v, 1);
            if ((r32 & 1) == 0) *(unsigned*)(Y + row * DI + col) = cvtpk(v, vn); } }
}
__device__ __forceinline__ int v_st2(int k, int c) { const int kk = (k & ~0xC) | ((k & 4) << 1) | ((k & 8) >> 1); return ((kk >> 3) * 2 + (c >> 5)) * 512 + ((kk & 7) * 32 + (c & 31)) * 2; }
__device__ __forceinline__ bf16x8 vfrag2(const LAS char* tile, int vrb, int d0, int ks) {
    const s16x4 l = vtr(tile + vrb + d0 * 512 + ks * 2048), h = vtr(tile + vrb + d0 * 512 + ks * 2048 + 1024);
    return (bf16x8){l[0], l[1], l[2], l[3], h[0], h[1], h[2], h[3]};
}
__device__ __forceinline__ void s3g_unit(LAS unsigned char* ldsu, int c, int g, const bf16* XBCC, const float* DT, const float* ACL, const bf16* SIN, const float* Dskip, bf16* Y, const int tid, const int dbgm) {
    LAS char* lds = (LAS char*)ldsu;
    const int wid = __builtin_amdgcn_readfirstlane(tid >> 6), lane = tid & 63, r32 = lane & 31, hi = lane >> 5;
    LAS char* Kt = lds;
    LAS char* Vt = lds + 65536;
    LAS float* acs = (LAS float*)(lds + 98304); LAS float* dts = acs + 256; LAS float* wsc = acs + 512 + wid * 32;
    const int vrb = fox::v_rd_base(lane), t0 = c * CHK, l0 = 32 * wid, trow = t0 + l0 + r32;
#pragma unroll 2
    for (int i = 0; i < 8; ++i) { int pc = tid + 512 * i; asm volatile("" : "+v"(pc)); const int row = pc >> 4, sc = (pc & 15) * 8;
        *(LAS v4u*)(Kt + (row >> 6) * 16384 + KSWZ(row & 63, sc * 2)) = *(const v4u*)(XBCC + (unsigned)((t0 + row) * CONVD + 4096 + g * 128 + sc)); }
    asm volatile("" ::: "memory");
    bf16x8 qr[8];
#pragma unroll
    for (int d0 = 0; d0 < 8; ++d0) qr[d0] = *(const bf16x8*)(XBCC + (size_t)trow * CONVD + 5120 + g * 128 + d0 * 16 + hi * 8);
    const int ntile = (dbgm & 1) ? 0 : (wid >> 1) + 1;
    const unsigned xoff0 = (unsigned)((t0 + (tid >> 3)) * CONVD + (tid & 7) * 8);
    const int xl0 = ((tid >> 3) >> 6) * 8192 + v_st2((tid >> 3) & 63, (tid & 7) * 8);
    v4u xr[4]; float acn = 0.f, dtn = 0.f, acl;
    { const int hd = g * 8;
#pragma unroll
      for (int i = 0; i < 4; ++i) xr[i] = *(const v4u*)(XBCC + (xoff0 + (unsigned)(i * 64 * CONVD + hd * 64)));
      if (tid < 256) { acn = ACL[(size_t)(t0 + tid) * 64 + hd]; dtn = DT[(size_t)(t0 + tid) * 64 + hd]; }
      acl = ACL[(size_t)trow * 64 + hd]; }
#pragma unroll 1
    for (int hh = 0; hh < 8; ++hh) { const int hd = g * 8 + hh;
#pragma unroll
        for (int i = 0; i < 4; ++i) *(LAS v4u*)(Vt + i * 8192 + xl0) = xr[i];
        if (tid < 256) { acs[tid] = acn; dts[tid] = dtn; }
        const float acl_c = acl;
        f32x16 o[2]; o[0] = f32x16{}; o[1] = f32x16{};
        { const bf16* sp = SIN + ((size_t)c * NHS + hd) * (HP * NST);
#pragma unroll
          for (int i = 0; i < 2; ++i)
#pragma unroll
              for (int ks = 0; ks < 8; ++ks) { const bf16x8 sf = *(const bf16x8*)(sp + (32 * i + r32) * NST + 16 * ks + 8 * hi); o[i] = __builtin_amdgcn_mfma_f32_32x32x16_bf16(qr[ks], sf, o[i], 0, 0, 0); } }
        if (hi == 0) wsc[r32] = __builtin_amdgcn_exp2f(acl_c);
        if (hh < 7) { const int hn = hd + 1;
#pragma unroll
            for (int i = 0; i < 4; ++i) xr[i] = *(const v4u*)(XBCC + (xoff0 + (unsigned)(i * 64 * CONVD + hn * 64)));
            if (tid < 256) { acn = ACL[(size_t)(t0 + tid) * 64 + hn]; dtn = DT[(size_t)(t0 + tid) * 64 + hn]; }
            acl = ACL[(size_t)trow * 64 + hn]; }
        __syncthreads();
#pragma unroll
        for (int i = 0; i < 2; ++i)
#pragma unroll
            for (int r = 0; r < 16; ++r) o[i][r] *= wsc[crow(r, hi)];
#pragma unroll 1
        for (int j = 0; j < ntile; ++j) {
            const LAS char* Kj = Kt + j * 16384; const LAS char* Vj = Vt + j * 8192;
            f32x16 p0 = f32x16{}, p1 = f32x16{};
#pragma unroll
            for (int d0 = 0; d0 < 8; ++d0) { const LAS char* a = Kj + KSWZ(r32, ((d0 & 3) * 16 + hi * 8) * 2) + (d0 >> 2) * 128;
                const bf16x8 b0 = *(const LAS bf16x8*)a, b1 = *(const LAS bf16x8*)(a + 32 * 256);
                p0 = __builtin_amdgcn_mfma_f32_32x32x16_bf16(b0, qr[d0], p0, 0, 0, 0);
                p1 = __builtin_amdgcn_mfma_f32_32x32x16_bf16(b1, qr[d0], p1, 0, 0, 0); }
            const int lrel = l0 + r32 - 64 * j;
#pragma unroll
            for (int jj = 0; jj < 4; ++jj) { const f32x4 a0 = *(const LAS f32x4*)(acs + 64 * j + 8 * jj + 4 * hi), a1 = *(const LAS f32x4*)(acs + 64 * j + 32 + 8 * jj + 4 * hi);
                const f32x4 e0 = *(const LAS f32x4*)(dts + 64 * j + 8 * jj + 4 * hi), e1 = *(const LAS f32x4*)(dts + 64 * j + 32 + 8 * jj + 4 * hi);
#pragma unroll
                for (int i = 0; i < 4; ++i) { const int r = 4 * jj + i, srel = 8 * jj + 4 * hi + i;
                    const float f0 = p0[r] * __builtin_amdgcn_exp2f(acl_c - a0[i]) * e0[i], f1 = p1[r] * __builtin_amdgcn_exp2f(acl_c - a1[i]) * e1[i];
                    p0[r] = (srel <= lrel) ? f0 : 0.f; p1[r] = (srel + 32 <= lrel) ? f1 : 0.f; } }
            bf16x8 pa0, pa1, pa2, pa3;
            FOX_PK4(p0, 0, pa0); FOX_PK4(p0, 8, pa1); FOX_PK4(p1, 0, pa2); FOX_PK4(p1, 8, pa3);
#pragma unroll
            for (int i = 0; i < 2; ++i) {
                o[i] = __builtin_amdgcn_mfma_f32_32x32x16_bf16(pa0, vfrag2(Vj, vrb, i, 0), o[i], 0, 0, 0);
                o[i] = __builtin_amdgcn_mfma_f32_32x32x16_bf16(pa1, vfrag2(Vj, vrb, i, 1), o[i], 0, 0, 0);
                o[i] = __builtin_amdgcn_mfma_f32_32x32x16_bf16(pa2, vfrag2(Vj, vrb, i, 2), o[i], 0, 0, 0);
                o[i] = __builtin_amdgcn_mfma_f32_32x32x16_bf16(pa3, vfrag2(Vj, vrb, i, 3), o[i], 0, 0, 0); }
        }
        const float Dh = Dskip[hd];
        { int ln2 = lane; asm volatile("" : "+v"(ln2));
          const unsigned yo = (unsigned)((t0 + l0 + 4 * (ln2 >> 5)) * DI + hd * 64 + (ln2 & 31));
          const LAS char* xs = Vt + (wid >> 1) * 8192 + (wid & 1) * 4096 + (ln2 >> 5) * 1024 + (ln2 & 31) * 2;
#pragma unroll
          for (int r = 0; r < 16; ++r) { const int rr = crow(r, 0);
#pragma unroll
            for (int i = 0; i < 2; ++i) {
                const float xv = __builtin_bit_cast(float, (unsigned)(*(const LAS unsigned short*)(xs + ((r >> 3) & 1) * 2048 + i * 512 + ((r & 3) + 4 * ((r >> 2) & 1)) * 64)) << 16);
                const float v = o[i][r] + Dh * xv, vn = __shfl_xor(v, 1);
                if ((ln2 & 1) == 0) *(unsigned*)(Y + (yo + (unsigned)(rr * DI + 32 * i))) = cvtpk(v, vn); } } }
        __syncthreads();
    }
}

#define S3P_QK(QR, J) const LAS char* Kj = Kt + (J) * 16384; const LAS char* Vj = vt_ + (J) * 8192; \
            f32x16 p0 = f32x16{}, p1 = f32x16{}; \
            _Pragma("unroll") for (int d0 = 0; d0 < 8; ++d0) { const LAS char* a = Kj + KSWZ(r32, ((d0 & 3) * 16 + hi * 8) * 2) + (d0 >> 2) * 128; \
                const bf16x8 b0 = *(const LAS bf16x8*)a, b1 = *(const LAS bf16x8*)(a + 32 * 256); \
                p0 = __builtin_amdgcn_mfma_f32_32x32x16_bf16(b0, QR[d0], p0, 0, 0, 0); \
                p1 = __builtin_amdgcn_mfma_f32_32x32x16_bf16(b1, QR[d0], p1, 0, 0, 0); }
#define S3P_PV(J) { bf16x8 pa0, pa1, pa2, pa3; \
            FOX_PK4(p0, 0, pa0); FOX_PK4(p0, 8, pa1); FOX_PK4(p1, 0, pa2); FOX_PK4(p1, 8, pa3); \
            _Pragma("unroll") for (int i = 0; i < 2; ++i) { \
                o[i] = __builtin_amdgcn_mfma_f32_32x32x16_bf16(pa0, vfrag2(Vj, vrb, i, 0), o[i], 0, 0, 0); \
                o[i] = __builtin_amdgcn_mfma_f32_32x32x16_bf16(pa1, vfrag2(Vj, vrb, i, 1), o[i], 0, 0, 0); \
                o[i] = __builtin_amdgcn_mfma_f32_32x32x16_bf16(pa2, vfrag2(Vj, vrb, i, 2), o[i], 0, 0, 0); \
                o[i] = __builtin_amdgcn_mfma_f32_32x32x16_bf16(pa3, vfrag2(Vj, vrb, i, 3), o[i], 0, 0, 0); } }
#define S3P_HALF(QR, RB, VT, BS, WTS, AEND, ACLC, HD) do { \
        const int rb_ = (RB), l0_ = 32 * rb_; const float aclc_ = (ACLC); const LAS char* vt_ = (VT); const LAS float* bs_ = (BS); const LAS float* wts_ = (WTS); const LAS float* aend_ = (AEND); \
        _Pragma("unroll") for (int i = 0; i < 2; ++i) _Pragma("unroll") for (int r = 0; r < 16; ++r) o[i][r] *= wsc[crow(r, hi)]; \
        const int ntile_ = (dbgm & 1) ? 0 : (rb_ >> 1) + 1; \
          \
        _Pragma("unroll 1") for (int j = 0; j + 1 < ntile_; ++j) { \
            S3P_QK(QR, j); \
            const float rs0_ = __builtin_amdgcn_exp2f(aclc_ - aend_[2 * j]), rs1_ = __builtin_amdgcn_exp2f(aclc_ - aend_[2 * j + 1]); \
            _Pragma("unroll") for (int jj = 0; jj < 4; ++jj) { const f32x4 w0 = *(const LAS f32x4*)(wts_ + 64 * j + 8 * jj + 4 * hi) * rs0_, w1 = *(const LAS f32x4*)(wts_ + 64 * j + 32 + 8 * jj + 4 * hi) * rs1_; \
                _Pragma("unroll") for (int i = 0; i < 4; ++i) { const int r = 4 * jj + i; p0[r] *= w0[i]; p1[r] *= w1[i]; } } \
            S3P_PV(j); } \
          \
        if (ntile_ > 0) { const int j = ntile_ - 1; \
          if ((rb_ & 1) == 0) { \
              \
            const LAS char* Kj = Kt + j * 16384; const LAS char* Vj = vt_ + j * 8192; \
            f32x16 p0 = f32x16{}; \
            _Pragma("unroll") for (int d0 = 0; d0 < 8; ++d0) { const LAS char* a = Kj + KSWZ(r32, ((d0 & 3) * 16 + hi * 8) * 2) + (d0 >> 2) * 128; \
                p0 = __builtin_amdgcn_mfma_f32_32x32x16_bf16(*(const LAS bf16x8*)a, QR[d0], p0, 0, 0, 0); } \
            _Pragma("unroll") for (int jj = 0; jj < 4; ++jj) { const f32x4 a0 = *(const LAS f32x4*)(bs_ + 64 * j + 8 * jj + 4 * hi); \
                _Pragma("unroll") for (int i = 0; i < 4; ++i) { const int r = 4 * jj + i, srel = 8 * jj + 4 * hi + i; \
                    const float f0 = p0[r] * __builtin_amdgcn_exp2f(aclc_ - a0[i]); p0[r] = (srel <= r32) ? f0 : 0.f; } } \
            bf16x8 pa0, pa1; FOX_PK4(p0, 0, pa0); FOX_PK4(p0, 8, pa1); \
            _Pragma("unroll") for (int i = 0; i < 2; ++i) { \
                o[i] = __builtin_amdgcn_mfma_f32_32x32x16_bf16(pa0, vfrag2(Vj, vrb, i, 0), o[i], 0, 0, 0); \
                o[i] = __builtin_amdgcn_mfma_f32_32x32x16_bf16(pa1, vfrag2(Vj, vrb, i, 1), o[i], 0, 0, 0); } \
          } else { \
              \
            S3P_QK(QR, j); \
            const float rs0_ = __builtin_amdgcn_exp2f(aclc_ - aend_[2 * j]); \
            _Pragma("unroll") for (int jj = 0; jj < 4; ++jj) { const f32x4 w0 = *(const LAS f32x4*)(wts_ + 64 * j + 8 * jj + 4 * hi) * rs0_, a1 = *(const LAS f32x4*)(bs_ + 64 * j + 32 + 8 * jj + 4 * hi); \
                _Pragma("unroll") for (int i = 0; i < 4; ++i) { const int r = 4 * jj + i, srel = 8 * jj + 4 * hi + i; \
                    p0[r] *= w0[i]; const float f1 = p1[r] * __builtin_amdgcn_exp2f(aclc_ - a1[i]); p1[r] = (srel <= r32) ? f1 : 0.f; } } \
            S3P_PV(j); } } \
        const float Dh = Dskip[(HD)]; \
          \
        { int ln2 = lane; asm volatile("" : "+v"(ln2)); \
          const LAS char* xs = vt_ + (rb_ >> 1) * 8192 + (rb_ & 1) * 4096 + (ln2 >> 5) * 1024 + (ln2 & 31) * 2; \
          LAS char* stw = stg + (ln2 >> 5) * (4 * 144) + (ln2 & 31) * 2; const LAS char* strd = stg + (ln2 >> 3) * 144 + (ln2 & 7) * 16; \
          const unsigned yo = (unsigned)((t0 + l0_ + (ln2 >> 3)) * DI + (HD) * 64 + (ln2 & 7) * 8); \
          _Pragma("unroll") for (int q = 0; q < 4; ++q) { \
            _Pragma("unroll") for (int rl = 0; rl < 4; ++rl) { const int r = 4 * q + rl; \
              _Pragma("unroll") for (int i = 0; i < 2; ++i) { \
                const float xv = __builtin_bit_cast(float, (unsigned)(*(const LAS unsigned short*)(xs + ((r >> 3) & 1) * 2048 + i * 512 + ((r & 3) + 4 * ((r >> 2) & 1)) * 64)) << 16); \
                *(LAS unsigned short*)(stw + rl * 144 + i * 64) = (unsigned short)cvtpk(o[i][r] + Dh * xv, 0.f); } } \
            LDS_WAIT(); asm volatile("" ::: "memory"); \
            const v4u d_ = *(const LAS v4u*)strd; \
            *(v4u*)(Y + (yo + (unsigned)(8 * q * DI))) = d_; \
            asm volatile("" ::: "memory"); } } \
    } while (0)
#define S3P_OINIT(QR, HD) do { o[0] = f32x16{}; o[1] = f32x16{}; const bf16* sp = SIN + ((size_t)c * NHS + (HD)) * (HP * NST); \
        _Pragma("unroll") for (int i = 0; i < 2; ++i) _Pragma("unroll") for (int ks = 0; ks < 8; ++ks) { const bf16x8 sf = *(const bf16x8*)(sp + (32 * i + r32) * NST + 16 * ks + 8 * hi); o[i] = __builtin_amdgcn_mfma_f32_32x32x16_bf16(QR[ks], sf, o[i], 0, 0, 0); } } while (0)
__device__ __forceinline__ void s3p_unit(LAS unsigned char* ldsu, int c, int g, const bf16* XBCC, const float* DT, const float* ACL, const bf16* SIN, const float* Dskip, bf16* Y, const int tid, const int dbgm) {
    LAS char* lds = (LAS char*)ldsu;
    const int wid = __builtin_amdgcn_readfirstlane(tid >> 6), lane = tid & 63, r32 = lane & 31, hi = lane >> 5;
    LAS char* Kt = lds;
    LAS char* Vt = lds + 65536;
    LAS float* acs = (LAS float*)(lds + 132096); LAS float* dts = acs + 512; LAS float* wsc = acs + 1024 + wid * 32; LAS float* aend = acs + 1280;
    LAS char* stg = lds + 137280 + wid * 1152;
    const int vrb = fox::v_rd_base(lane), t0 = c * CHK, rbA = wid, rbB = 7 - wid;
    { v4u braw[8];
#pragma unroll
      for (int i = 0; i < 8; ++i) { int pc = tid + 512 * i; asm volatile("" : "+v"(pc)); const int row = pc >> 4, sc = (pc & 15) * 8; braw[i] = *(const v4u*)(XBCC + (unsigned)((t0 + row) * CONVD + 4096 + g * 128 + sc)); }
#pragma unroll
      for (int i = 0; i < 8; ++i) { int pc = tid + 512 * i; asm volatile("" : "+v"(pc)); const int row = pc >> 4, sc = (pc & 15) * 8; *(LAS v4u*)(Kt + (row >> 6) * 16384 + KSWZ(row & 63, sc * 2)) = braw[i]; } }
    asm volatile("" ::: "memory");
    bf16x8 qA[8], qB[8];
    const int trowA = t0 + 32 * rbA + r32, trowB = t0 + 32 * rbB + r32;
#pragma unroll
    for (int d0 = 0; d0 < 8; ++d0) { qA[d0] = *(const bf16x8*)(XBCC + (size_t)trowA * CONVD + 5120 + g * 128 + d0 * 16 + hi * 8); qB[d0] = *(const bf16x8*)(XBCC + (size_t)trowB * CONVD + 5120 + g * 128 + d0 * 16 + hi * 8); }
    const unsigned xoff0 = (unsigned)((t0 + (tid >> 3)) * CONVD + (tid & 7) * 8);
    const int xl0 = ((tid >> 3) >> 6) * 8192 + v_st2((tid >> 3) & 63, (tid & 7) * 8);
    const int hsel = wid >> 2;
#define S3P_EL(v) int v = lane; asm volatile("" : "+v"(v)); v += (wid & 3) * 64
    v4u xr[8]; float acn, dtn, aclA, aclB;
    { const int hd = g * 8;
#pragma unroll
      for (int i = 0; i < 4; ++i) { xr[i] = *(const v4u*)(XBCC + (xoff0 + (unsigned)(i * 64 * CONVD + hd * 64))); xr[4 + i] = *(const v4u*)(XBCC + (xoff0 + (unsigned)(i * 64 * CONVD + (hd + 1) * 64))); }
      S3P_EL(el); acn = ACL[(unsigned)((t0 + el) * 64 + hd + hsel)]; dtn = DT[(unsigned)((t0 + el) * 64 + hd + hsel)];
      aclA = ACL[(unsigned)(trowA * 64 + hd)]; aclB = ACL[(unsigned)(trowB * 64 + hd + 1)]; }
#pragma unroll 1
    for (int pp = 0; pp < 4; ++pp) { const int hA = g * 8 + 2 * pp, hB = hA + 1;
#pragma unroll
        for (int i = 0; i < 4; ++i) { *(LAS v4u*)(Vt + i * 8192 + xl0) = xr[i]; *(LAS v4u*)(Vt + 32768 + i * 8192 + xl0) = xr[4 + i]; }
        { S3P_EL(el); const float e31 = __builtin_bit_cast(float, __builtin_amdgcn_readlane(__builtin_bit_cast(int, acn), 31)), e63 = __builtin_bit_cast(float, __builtin_amdgcn_readlane(__builtin_bit_cast(int, acn), 63));
          const float aen = (el & 32) ? e63 : e31;
          acs[hsel * 256 + el] = acn - __builtin_amdgcn_logf(dtn); dts[hsel * 256 + el] = __builtin_amdgcn_exp2f(aen - acn) * dtn; if ((el & 31) == 31) aend[hsel * 8 + (el >> 5)] = acn; }
        const float aclA_c = aclA, aclB_c = aclB;
        f32x16 o[2];
        S3P_OINIT(qA, hA);
        if (hi == 0) wsc[r32] = __builtin_amdgcn_exp2f(aclA_c);
        if (pp < 3) { const int hn = hA + 2;
#pragma unroll
            for (int i = 0; i < 4; ++i) { xr[i] = *(const v4u*)(XBCC + (xoff0 + (unsigned)(i * 64 * CONVD + hn * 64))); xr[4 + i] = *(const v4u*)(XBCC + (xoff0 + (unsigned)(i * 64 * CONVD + (hn + 1) * 64))); }
            S3P_EL(el); acn = ACL[(unsigned)((t0 + el) * 64 + hn + hsel)]; dtn = DT[(unsigned)((t0 + el) * 64 + hn + hsel)];
            aclA = ACL[(unsigned)(trowA * 64 + hn)]; aclB = ACL[(unsigned)(trowB * 64 + hn + 1)]; }
        __syncthreads();
        S3P_HALF(qA, rbA, Vt, acs, dts, aend, aclA_c, hA);
        S3P_OINIT(qB, hB);
        if (hi == 0) wsc[r32] = __builtin_amdgcn_exp2f(aclB_c);
        LDS_WAIT(); asm volatile("" ::: "memory");
        S3P_HALF(qB, rbB, Vt + 32768, acs + 256, dts + 256, aend + 8, aclB_c, hB);
        __syncthreads();
    }
}
#undef S3P_HALF
#undef S3P_QK
#undef S3P_PV
#undef S3P_EL
#undef S3P_OINIT
}
namespace peer {
using fox::crow;
__device__ __forceinline__ void top16_of_128(float a0, float a1, int lane, float& ts, int& ti) {
    ts = 0.f; ti = 0;
    for (int r = 0; r < 16; ++r) {
        const float m = wave_max(fmaxf(a0, a1));
        const unsigned long long b0 = __ballot(a0 == m);
        int idx;
        if (b0) { const int l = __ffsll((long long)b0) - 1; idx = l; if (lane == l) a0 = -__builtin_inff(); }
        else { const unsigned long long b1 = __ballot(a1 == m); const int l = __ffsll((long long)b1) - 1; idx = 64 + l; if (lane == l) a1 = -__builtin_inff(); }
        if (lane == r) { ts = m; ti = idx; }
    }
}
__device__ __forceinline__ void topk_unit(LAS unsigned char* ldsu, int tt, int h, const bf16* PQ, const bf16* SK, int* EIDX, float* GATE, const int tid, const float* SKF) {
    LAS float* scv = (LAS float*)ldsu;
    const int wid = __builtin_amdgcn_readfirstlane(tid >> 6), lane = tid & 63, r32 = lane & 31, hi = lane >> 5;
    const int t0 = tt * 32;
#if DBG_SCORES
    for (int i = tid; i < 32 * 2 * 128; i += 512) { const int key = i & 127, cc = (i >> 7) & 1, tok = i >> 8;
        const bf16* qp = PQ + (size_t)(t0 + tok) * DM + h * 256 + cc * 128; const float* kp = SKF + ((size_t)(h * 2 + cc) * NKEY + key) * 128;
        float s = 0.f; for (int d = 0; d < 128; ++d) s += __builtin_bit_cast(float, (unsigned)qp[d] << 16) * kp[d];
        scv[(tok * 2 + cc) * 128 + key] = s; }
#else
    { const int cc = wid >> 2, kb = wid & 3;
      f32x16 acc = f32x16{};
      const bf16* qp = PQ + (size_t)(t0 + r32) * DM + h * 256 + cc * 128 + 8 * hi;
      const bf16* kp = SK + ((size_t)(h * 2 + cc) * NKEY + 32 * kb + r32) * 128 + 8 * hi;
#pragma unroll
      for (int ks = 0; ks < 8; ++ks) { const bf16x8 qa = *(const bf16x8*)(qp + 16 * ks), kf = *(const bf16x8*)(kp + 16 * ks); acc = __builtin_amdgcn_mfma_f32_32x32x16_bf16(qa, kf, acc, 0, 0, 0); }
#pragma unroll
      for (int r = 0; r < 16; ++r) scv[(crow(r, hi) * 2 + cc) * 128 + 32 * kb + r32] = acc[r]; }
#endif
    __syncthreads();
    for (int q = 0; q < 4; ++q) { const int tl = wid * 4 + q, t = t0 + tl;
        const LAS float* s1 = scv + (tl * 2) * 128; const LAS float* s2 = s1 + 128;
#if DBG_BRUTE
        float tv = 0.f; int te = 0; float prev = __builtin_inff();
        for (int r = 0; r < 16; ++r) {
            float bv = -__builtin_inff(); int bi = 0;
            for (int kk = 0; kk < 2; ++kk) { const int k1 = lane + 64 * kk; const float a = s1[k1];
                for (int k2 = 0; k2 < 128; ++k2) { const float v = a + s2[k2]; if (v < prev && v > bv) { bv = v; bi = k1 * 128 + k2; } } }
            const float m = wave_max(bv);
            const unsigned long long b = __ballot(bv == m); const int l = __ffsll((long long)b) - 1; const int e = __shfl(bi, l);
            if (lane == r) { tv = m; te = e; }
            prev = m;
        }
#else
        float ts1, ts2; int ti1, ti2;
        top16_of_128(s1[lane], s1[lane + 64], lane, ts1, ti1);
        top16_of_128(s2[lane], s2[lane + 64], lane, ts2, ti2);
        const float sj = __shfl(ts2, lane & 15); const int ij = __shfl(ti2, lane & 15);
        float cv[4]; int ci[4];
#pragma unroll
        for (int k = 0; k < 4; ++k) { const int i = (lane >> 4) + 4 * k; cv[k] = __shfl(ts1, i) + sj; ci[k] = __shfl(ti1, i) * NKEY + ij; }
        float tv = 0.f; int te = 0;
        for (int r = 0; r < 16; ++r) {
            const float m = wave_max(fmaxf(fmaxf(cv[0], cv[1]), fmaxf(cv[2], cv[3])));
            int e = 0; bool found = false;
#pragma unroll
            for (int k = 0; k < 4; ++k) { if (!found) { const unsigned long long b = __ballot(cv[k] == m);
                    if (b) { const int l = __ffsll((long long)b) - 1; e = __shfl(ci[k], l); if (lane == l) cv[k] = -__builtin_inff(); found = true; } } }
            if (lane == r) { tv = m; te = e; }
        }
#endif
        const float mx = __shfl(tv, 0);
        const float ex = lane < 16 ? __expf(tv - mx) : 0.f;
        const float den = wave_sum(ex);
        if (lane < 16) { EIDX[(size_t)t * 128 + h * 16 + lane] = te; GATE[(size_t)t * 128 + h * 16 + lane] = ex / den; }
    }
    __syncthreads();
}
__device__ __forceinline__ unsigned f2key(float s) { const unsigned u = __float_as_uint(s); return u ^ (unsigned)(((int)u >> 31) | (int)0x80000000); }
__device__ __forceinline__ float key2f(unsigned k) { const unsigned u = k ^ (unsigned)((~((int)k >> 31)) | (int)0x80000000); return __uint_as_float(u); }
__device__ __forceinline__ unsigned umin_(unsigned a, unsigned b) { return a < b ? a : b; }
__device__ __forceinline__ unsigned umax_(unsigned a, unsigned b) { return a > b ? a : b; }
__device__ __forceinline__ void bsort16(unsigned (&a)[16]) {
#pragma unroll
    for (int k = 2; k <= 16; k <<= 1)
#pragma unroll
        for (int j = k >> 1; j > 0; j >>= 1)
#pragma unroll
            for (int i = 0; i < 16; ++i) { const int l = i ^ j; if (l > i) { const bool up = (i & k) == 0; const unsigned lo = umin_(a[i], a[l]), hi = umax_(a[i], a[l]); a[i] = up ? lo : hi; a[l] = up ? hi : lo; } }
}
__device__ __forceinline__ void bmerge16(unsigned (&a)[16]) {
#pragma unroll
    for (int j = 8; j > 0; j >>= 1)
#pragma unroll
        for (int i = 0; i < 16; ++i) { const int l = i ^ j; if (l > i) { const unsigned lo = umin_(a[i], a[l]), hi = umax_(a[i], a[l]); a[i] = lo; a[l] = hi; } }
}
__device__ __forceinline__ void mprune16(unsigned (&r)[16], const unsigned (&g)[16]) {
#pragma unroll
    for (int i = 0; i < 16; ++i) r[i] = umax_(r[i], g[15 - i]);
    bmerge16(r);
}
__device__ __forceinline__ void pair_top16(unsigned (&r)[16]) {
    unsigned a[16], b[16];
#pragma unroll
    for (int i = 0; i < 16; ++i) { auto rr = __builtin_amdgcn_permlane32_swap(r[i], r[i], false, false); a[i] = rr[0]; b[i] = rr[1]; }
#pragma unroll
    for (int i = 0; i < 16; ++i) r[i] = umax_(a[i], b[15 - i]);
}
constexpr int TROW = 2048;
__device__ __forceinline__ void tab_fp4_row(const f32x4 (&v)[8], unsigned char* dst, float* scl, int r, int lane) {
    float am = 0.f;
#pragma unroll
    for (int i = 0; i < 8; ++i) am = fmaxf(am, fmaxf(fmaxf(fabsf(v[i][0]), fabsf(v[i][1])), fmaxf(fabsf(v[i][2]), fabsf(v[i][3]))));
    am = wave_max(am);
    const float sc = am > 0.f ? 6.f / am : 1.f;
    v4u w;
#pragma unroll
    for (int j = 0; j < 4; ++j) { const f32x4 a = v[2 * j] * sc, b = v[2 * j + 1] * sc; unsigned p = 0;
        p = __builtin_amdgcn_cvt_scalef32_pk_fp4_f32(p, a[0], a[1], 1.0f, 0); p = __builtin_amdgcn_cvt_scalef32_pk_fp4_f32(p, a[2], a[3], 1.0f, 1);
        p = __builtin_amdgcn_cvt_scalef32_pk_fp4_f32(p, b[0], b[1], 1.0f, 2); p = __builtin_amdgcn_cvt_scalef32_pk_fp4_f32(p, b[2], b[3], 1.0f, 3); w[j] = p; }
    *(v4u*)(dst + (size_t)r * TROW + 16 * lane) = w;
    if (lane == 0) scl[r] = am > 0.f ? am * (1.f / 6.f) : 1.f;
}

struct TabStream { const float* srcA; const float* srcB; unsigned char* dstA; unsigned char* dstB; float* sclA; float* sclB; int gw; };
template <int NR> __device__ __forceinline__ void ts_issue(const TabStream& T, int q, f32x4 (&v)[8], int lane) {
    const float* sp = (NR == 16 && q < 8) ? T.srcA + (size_t)(T.gw + 2048 * q) * DM : T.srcB + (size_t)(T.gw + 2048 * (q & 7)) * DM; row_load_nt(sp, lane, v);
}
template <int NR> __device__ __forceinline__ void ts_retire(const TabStream& T, int q, const f32x4 (&v)[8], int lane) {
    if (NR == 16 && q < 8) tab_fp4_row(v, T.dstA, T.sclA, T.gw + 2048 * q, lane); else tab_fp4_row(v, T.dstB, T.sclB, T.gw + 2048 * (q & 7), lane);
}
#define TS_AT(j) do { const int j_ = (j); if (NR == 16 || (NR == 8 && (j_ & 1) == 0)) { const int q_ = NR == 16 ? j_ : (j_ >> 1); \
        if (q_ & 1) { if (q_ >= 2) ts_retire<NR>(TS, q_ - 2, tv1, TK_LANE()); if (q_ < NR) ts_issue<NR>(TS, q_, tv1, TK_LANE()); } \
        else        { if (q_ >= 2) ts_retire<NR>(TS, q_ - 2, tv0, TK_LANE()); if (q_ < NR) ts_issue<NR>(TS, q_, tv0, TK_LANE()); } } SBAR(); } while (0)
template <int NR> __device__ __forceinline__ void topk2_unit(LAS unsigned char* ldsw  , int tt, int h, const bf16* PQ, const bf16* SK, int* EIDX, float* GATE, const TabStream& TS) {
#define TK_LANE() ([]() { unsigned m_ = ~0u; asm volatile("" : "+s"(m_)); return (int)__builtin_amdgcn_mbcnt_hi(m_, __builtin_amdgcn_mbcnt_lo(m_, 0u)); }())
    const int t0 = tt * 32; const int hi = TK_LANE() >> 5;
    f32x4 tv0[8], tv1[8];
    unsigned S[2][16];
#pragma unroll
    for (int cc = 0; cc < 2; ++cc) {
        f32x16 acc[4];
#pragma unroll
        for (int kb = 0; kb < 4; ++kb) acc[kb] = f32x16{};
        const int r32a = TK_LANE() & 31;
        const bf16* qp = PQ + (size_t)(t0 + r32a) * DM + h * 256 + cc * 128 + 8 * hi;
        const bf16* kp = SK + ((size_t)(h * 2 + cc) * NKEY + r32a) * 128 + 8 * hi;
#pragma unroll 2
        for (int ks = 0; ks < 8; ++ks) { const bf16x8 qf = *(const bf16x8*)(qp + 16 * ks);
#pragma unroll
            for (int kb = 0; kb < 4; ++kb) { const bf16x8 kf = *(const bf16x8*)(kp + (size_t)kb * 32 * 128 + 16 * ks); acc[kb] = __builtin_amdgcn_mfma_f32_32x32x16_bf16(kf, qf, acc[kb], 0, 0, 0); } }
        TS_AT(6 * cc);
        const unsigned hi4 = 4u * hi;
        unsigned R[16];
#pragma unroll
        for (int kb = 0; kb < 4; ++kb) { unsigned g[16];
#pragma unroll
            for (int r = 0; r < 16; ++r) g[r] = (f2key(acc[kb][r]) & 0xFFFFFF80u) | (unsigned)(32 * kb + (r & 3) + 8 * (r >> 2)) | hi4;
            bsort16(g);
            if (kb == 0) {
#pragma unroll
                for (int i = 0; i < 16; ++i) R[i] = g[i]; }
            else mprune16(R, g);
            TS_AT(6 * cc + 1 + kb); }
        pair_top16(R);
        bmerge16(R);
#pragma unroll
        for (int i = 0; i < 16; ++i) S[cc][i] = R[i];
        TS_AT(6 * cc + 5);
        SBAR();
    }
    { LAS unsigned* tb = (LAS unsigned*)ldsw + (TK_LANE() & 31) * 8 + hi * 4;
#pragma unroll
      for (int w4 = 0; w4 < 4; ++w4) { unsigned pk = 0;
#pragma unroll
          for (int b = 0; b < 4; ++b) { const unsigned kx = hi ? S[1][4 * w4 + b] : S[0][4 * w4 + b]; pk |= (kx & 127u) << (8 * b); }
          tb[w4] = pk; } }
    unsigned R[16];
    { float X[16], Y[16];
#pragma unroll
      for (int p_ = 0; p_ < 16; ++p_) { const float fa = key2f(S[0][p_] & 0xFFFFFF80u), fb = key2f(S[1][p_] & 0xFFFFFF80u); X[p_] = hi ? fb : fa; Y[p_] = hi ? fa : fb; }
#define TK_CAND(xp, yp) ((f2key(X[xp] + Y[yp]) & 0xFFFFFF00u) | (hi ? (unsigned)(16 * (yp) + (xp)) : (unsigned)(16 * (xp) + (yp))))
      TS_AT(12);
      { unsigned c_[16];
#pragma unroll
        for (int p_ = 0; p_ < 16; ++p_) c_[p_] = TK_CAND(15, p_);
        R[0] = hi ? 0u : c_[0];
#pragma unroll
        for (int p_ = 1; p_ < 16; ++p_) R[p_] = hi ? c_[p_ - 1] : c_[p_]; }
      TS_AT(13);
      unsigned g[16];
      g[0] = TK_CAND(14, 13); g[1] = TK_CAND(14, 12); g[2] = TK_CAND(14, 11); g[3] = TK_CAND(14, 10); g[4] = TK_CAND(14, 9); g[5] = TK_CAND(14, 8);
      g[6] = TK_CAND(13, 12); g[7] = TK_CAND(13, 11);
      g[8] = hi ? 0u : TK_CAND(14, 14); g[9] = hi ? 0u : TK_CAND(13, 13); g[10] = hi ? 0u : TK_CAND(12, 12);
      g[11] = 0u; g[12] = 0u; g[13] = 0u; g[14] = 0u; g[15] = 0u;
#undef TK_CAND
      bsort16(g);
      TS_AT(14);
      mprune16(R, g);
      TS_AT(15); }
    pair_top16(R);
    float v[16]; float mx = -__builtin_inff();
#pragma unroll
    for (int i = 0; i < 16; ++i) { v[i] = key2f(R[i] & 0xFFFFFF00u); mx = fmaxf(mx, v[i]); }
    float den = 0.f;
#pragma unroll
    for (int i = 0; i < 16; ++i) { v[i] = __expf(v[i] - mx); den += v[i]; }
    const float rden = 1.f / den;
    LDS_WAIT();
    const int r32 = TK_LANE() & 31;
    const LAS unsigned char* tbb = (const LAS unsigned char*)ldsw + r32 * 32;
    int eo[8]; float go[8];
#pragma unroll
    for (int k = 0; k < 8; ++k) { const unsigned w = hi ? R[8 + k] : R[k]; const unsigned code = w & 255u;
        eo[k] = (int)tbb[code >> 4] * NKEY + (int)tbb[16 + (code & 15u)]; go[k] = (hi ? v[8 + k] : v[k]) * rden; }
    const size_t ob = (size_t)(t0 + r32) * 128 + h * 16 + 8 * hi;
    *(v4u*)(EIDX + ob) = (v4u){(unsigned)eo[0], (unsigned)eo[1], (unsigned)eo[2], (unsigned)eo[3]}; *(v4u*)(EIDX + ob + 4) = (v4u){(unsigned)eo[4], (unsigned)eo[5], (unsigned)eo[6], (unsigned)eo[7]};
    *(f32x4*)(GATE + ob) = (f32x4){go[0], go[1], go[2], go[3]}; *(f32x4*)(GATE + ob + 4) = (f32x4){go[4], go[5], go[6], go[7]};
    LDS_WAIT();
    if (NR >= 2) { ts_retire<NR>(TS, NR - 2, tv0, TK_LANE()); ts_retire<NR>(TS, NR - 1, tv1, TK_LANE()); }
}
#undef TS_AT
#undef TK_LANE
__device__ __forceinline__ void expert_phase(const Frame& F, float* H, bf16* XN, const bf16* U, const bf16* V, const int* EIDX, const float* GATE, const float* nw, const bool dbg_skip, const bool dry, const float* UF, const float* VF) {
    const int lane = F.lane;
    for (int t = F.gw; t < SEQ; t += F.NGW) {
        v4u xr[4];
#pragma unroll
        for (int j = 0; j < 4; ++j) xr[j] = *(const v4u*)(XN + (size_t)t * DM + lane * 8 + 512 * j);
        const int e_lo = EIDX[(size_t)t * 128 + lane], e_hi = EIDX[(size_t)t * 128 + 64 + lane];
        const float g_lo = GATE[(size_t)t * 128 + lane], g_hi = GATE[(size_t)t * 128 + 64 + lane];
        float acc[32];
#pragma unroll
        for (int i = 0; i < 32; ++i) acc[i] = 0.f;
        for (int e0 = dbg_skip ? 128 : 0; e0 < 128; e0 += 4) {
            v4u ur[4][4], vr[4][4]; float gg[4];
#pragma unroll
            for (int q = 0; q < 4; ++q) { const int e = e0 + q; const int ei = __builtin_amdgcn_readlane(e < 64 ? e_lo : e_hi, e & 63);
                gg[q] = __builtin_bit_cast(float, __builtin_amdgcn_readlane(__builtin_bit_cast(int, e < 64 ? g_lo : g_hi), e & 63));
#if DBG_F32TAB
                const float* up = UF + (size_t)ei * DM + lane * 8; const float* vp = VF + (size_t)ei * DM + lane * 8;
#pragma unroll
                for (int j = 0; j < 4; ++j) { const f32x4 a0 = *(const f32x4*)(up + 512 * j), a1 = *(const f32x4*)(up + 512 * j + 4), b0 = *(const f32x4*)(vp + 512 * j), b1 = *(const f32x4*)(vp + 512 * j + 4);
                    ur[q][j] = (v4u){cvtpk(a0[0], a0[1]), cvtpk(a0[2], a0[3]), cvtpk(a1[0], a1[1]), cvtpk(a1[2], a1[3])}; vr[q][j] = (v4u){cvtpk(b0[0], b0[1]), cvtpk(b0[2], b0[3]), cvtpk(b1[0], b1[1]), cvtpk(b1[2], b1[3])}; } }
#else
                const bf16* up = U + (size_t)ei * DM + lane * 8; const bf16* vp = V + (size_t)ei * DM + lane * 8;
#pragma unroll
                for (int j = 0; j < 4; ++j) { ur[q][j] = *(const v4u*)(up + 512 * j); vr[q][j] = *(const v4u*)(vp + 512 * j); } }
#endif
#pragma unroll
            for (int q = 0; q < 4; ++q) { float d = 0.f;
#pragma unroll
                for (int j = 0; j < 4; ++j) {
                    d += bflo(ur[q][j].x) * bflo(xr[j].x) + bfhi(ur[q][j].x) * bfhi(xr[j].x);
                    d += bflo(ur[q][j].y) * bflo(xr[j].y) + bfhi(ur[q][j].y) * bfhi(xr[j].y);
                    d += bflo(ur[q][j].z) * bflo(xr[j].z) + bfhi(ur[q][j].z) * bfhi(xr[j].z);
                    d += bflo(ur[q][j].w) * bflo(xr[j].w) + bfhi(ur[q][j].w) * bfhi(xr[j].w); }
                d = wave_sum(d);
                const float a = gg[q] * 0.5f * d * (1.f + erff(d * 0.70710678118654752f));
#pragma unroll
                for (int j = 0; j < 4; ++j) {
                    acc[8 * j + 0] += a * bflo(vr[q][j].x); acc[8 * j + 1] += a * bfhi(vr[q][j].x); acc[8 * j + 2] += a * bflo(vr[q][j].y); acc[8 * j + 3] += a * bfhi(vr[q][j].y);
                    acc[8 * j + 4] += a * bflo(vr[q][j].z); acc[8 * j + 5] += a * bfhi(vr[q][j].z); acc[8 * j + 6] += a * bflo(vr[q][j].w); acc[8 * j + 7] += a * bfhi(vr[q][j].w); } }
        }
        f32x4 hv[8]; row_load(H + (size_t)t * DM, lane, hv);
#pragma unroll
        for (int j = 0; j < 8; ++j) { hv[j][0] += acc[4 * j]; hv[j][1] += acc[4 * j + 1]; hv[j][2] += acc[4 * j + 2]; hv[j][3] += acc[4 * j + 3]; }
#pragma unroll
        for (int j = 0; j < 4; ++j) { if (!dry) { *(f32x4*)(H + (size_t)t * DM + lane * 8 + 512 * j) = hv[2 * j]; *(f32x4*)(H + (size_t)t * DM + lane * 8 + 512 * j + 4) = hv[2 * j + 1]; } }
        const float rstd = row_rstd(hv);
        if (!dry) row_store_norm(hv, rstd, nw, XN + (size_t)t * DM, lane);
    }
}
typedef float f2v __attribute__((ext_vector_type(2)));
__device__ __forceinline__ void tab_fp8_phase(const Frame& F, const float* src, unsigned char* dst, float* scl, int rows) {
    const int lane = F.lane;
    for (int r = F.gw; r < rows; r += F.NGW) { const float* row = src + (size_t)r * DM + 16 * lane;
        f32x4 v[8]; float am = 0.f;
#pragma unroll
        for (int j = 0; j < 2; ++j)
#pragma unroll
            for (int q4 = 0; q4 < 4; ++q4) { const f32x4 x = *(const f32x4*)(row + 1024 * j + 4 * q4); v[4 * j + q4] = x; am = fmaxf(am, fmaxf(fmaxf(fabsf(x[0]), fabsf(x[1])), fmaxf(fabsf(x[2]), fabsf(x[3])))); }
        am = wave_max(am);
        const float sc = am > 0.f ? 224.f / am : 1.f;
#pragma unroll
        for (int j = 0; j < 2; ++j) { v4u w;
#pragma unroll
            for (int q4 = 0; q4 < 4; ++q4) { const f32x4 x = v[4 * j + q4] * sc; int p = __builtin_amdgcn_cvt_pk_fp8_f32(x[0], x[1], 0, false); p = __builtin_amdgcn_cvt_pk_fp8_f32(x[2], x[3], p, true); w[q4] = (unsigned)p; }
            *(v4u*)(dst + (size_t)r * DM + 16 * lane + 1024 * j) = w; }
        if (lane == 0) scl[r] = am > 0.f ? am * (1.f / 224.f) : 1.f;
    }
}
__device__ __forceinline__ void expert8_phase(const Frame& F, float* H, bf16* XN, const unsigned char* U8, const unsigned char* V8, const float* SU, const float* SV, const int* EIDX, const float* GATE, const float* nw, const bool dry) {
    const int lane = F.lane;
    for (int t = F.gw; t < SEQ; t += F.NGW) {
        float xf[32];
#pragma unroll
        for (int j = 0; j < 2; ++j) { const v4u a = *(const v4u*)(XN + (size_t)t * DM + 16 * lane + 1024 * j), b = *(const v4u*)(XN + (size_t)t * DM + 16 * lane + 1024 * j + 8);
            xf[16 * j + 0] = bflo(a.x); xf[16 * j + 1] = bfhi(a.x); xf[16 * j + 2] = bflo(a.y); xf[16 * j + 3] = bfhi(a.y); xf[16 * j + 4] = bflo(a.z); xf[16 * j + 5] = bfhi(a.z); xf[16 * j + 6] = bflo(a.w); xf[16 * j + 7] = bfhi(a.w);
            xf[16 * j + 8] = bflo(b.x); xf[16 * j + 9] = bfhi(b.x); xf[16 * j + 10] = bflo(b.y); xf[16 * j + 11] = bfhi(b.y); xf[16 * j + 12] = bflo(b.z); xf[16 * j + 13] = bfhi(b.z); xf[16 * j + 14] = bflo(b.w); xf[16 * j + 15] = bfhi(b.w); }
        const int e_lo = EIDX[(size_t)t * 128 + lane], e_hi = EIDX[(size_t)t * 128 + 64 + lane];
        const float g_lo = GATE[(size_t)t * 128 + lane], g_hi = GATE[(size_t)t * 128 + 64 + lane];
        float acc[32];
#pragma unroll
        for (int i = 0; i < 32; ++i) acc[i] = 0.f;
        for (int e0 = 0; e0 < 128; e0 += 4) {
            v4u ur[4][2], vr[4][2]; float gg[4], su[4], sv[4];
#pragma unroll
            for (int q = 0; q < 4; ++q) { const int e = e0 + q; const int ei = __builtin_amdgcn_readlane(e < 64 ? e_lo : e_hi, e & 63);
                gg[q] = __builtin_bit_cast(float, __builtin_amdgcn_readlane(__builtin_bit_cast(int, e < 64 ? g_lo : g_hi), e & 63));
                su[q] = SU[ei]; sv[q] = SV[ei];
                const unsigned char* up = U8 + (size_t)ei * DM + 16 * lane; const unsigned char* vp = V8 + (size_t)ei * DM + 16 * lane;
#pragma unroll
                for (int j = 0; j < 2; ++j) { ur[q][j] = *(const v4u*)(up + 1024 * j); vr[q][j] = *(const v4u*)(vp + 1024 * j); } }
#pragma unroll
            for (int q = 0; q < 4; ++q) { float d = 0.f;
#pragma unroll
                for (int j = 0; j < 2; ++j)
#pragma unroll
                    for (int w = 0; w < 4; ++w) { const f2v lo = __builtin_amdgcn_cvt_pk_f32_fp8((int)ur[q][j][w], false), hi2 = __builtin_amdgcn_cvt_pk_f32_fp8((int)ur[q][j][w], true);
                        d += lo.x * xf[16 * j + 4 * w] + lo.y * xf[16 * j + 4 * w + 1]; d += hi2.x * xf[16 * j + 4 * w + 2] + hi2.y * xf[16 * j + 4 * w + 3]; }
                d = wave_sum(d) * su[q];
                const float a = gg[q] * sv[q] * 0.5f * d * (1.f + erff(d * 0.70710678118654752f));
#pragma unroll
                for (int j = 0; j < 2; ++j)
#pragma unroll
                    for (int w = 0; w < 4; ++w) { const f2v lo = __builtin_amdgcn_cvt_pk_f32_fp8((int)vr[q][j][w], false), hi2 = __builtin_amdgcn_cvt_pk_f32_fp8((int)vr[q][j][w], true);
                        acc[16 * j + 4 * w] += a * lo.x; acc[16 * j + 4 * w + 1] += a * lo.y; acc[16 * j + 4 * w + 2] += a * hi2.x; acc[16 * j + 4 * w + 3] += a * hi2.y; } }
        }
        float* hrow = H + (size_t)t * DM + 16 * lane; float ss = 0.f;
#pragma unroll
        for (int j = 0; j < 2; ++j)
#pragma unroll
            for (int q4 = 0; q4 < 4; ++q4) { f32x4 hv = *(const f32x4*)(hrow + 1024 * j + 4 * q4);
                hv[0] += acc[16 * j + 4 * q4]; hv[1] += acc[16 * j + 4 * q4 + 1]; hv[2] += acc[16 * j + 4 * q4 + 2]; hv[3] += acc[16 * j + 4 * q4 + 3];
                acc[16 * j + 4 * q4] = hv[0]; acc[16 * j + 4 * q4 + 1] = hv[1]; acc[16 * j + 4 * q4 + 2] = hv[2]; acc[16 * j + 4 * q4 + 3] = hv[3];
                ss += (hv[0] * hv[0] + hv[1] * hv[1]) + (hv[2] * hv[2] + hv[3] * hv[3]);
                if (!dry) *(f32x4*)(hrow + 1024 * j + 4 * q4) = hv; }
        const float rstd = 1.f / sqrtf(wave_sum(ss) * (1.f / DM) + RMS_EPS);
        if (!dry) {
#pragma unroll
            for (int j = 0; j < 2; ++j)
#pragma unroll
                for (int hf = 0; hf < 2; ++hf) { const f32x4 w0 = *(const f32x4*)(nw + 16 * lane + 1024 * j + 8 * hf), w1 = *(const f32x4*)(nw + 16 * lane + 1024 * j + 8 * hf + 4); const int b = 16 * j + 8 * hf;
                    v4u o; o.x = cvtpk(acc[b] * rstd * w0[0], acc[b + 1] * rstd * w0[1]); o.y = cvtpk(acc[b + 2] * rstd * w0[2], acc[b + 3] * rstd * w0[3]);
                    o.z = cvtpk(acc[b + 4] * rstd * w1[0], acc[b + 5] * rstd * w1[1]); o.w = cvtpk(acc[b + 6] * rstd * w1[2], acc[b + 7] * rstd * w1[3]);
                    *(v4u*)(XN + (size_t)t * DM + 16 * lane + 1024 * j + 8 * hf) = o; } }
    }
}
__device__ __forceinline__ void tab_fp4_phase(const Frame& F, const float* src, unsigned char* dst, float* scl, int rows) {
    const int lane = F.lane, st = F.NGW;
    int r = F.gw; if (r >= rows) return;
    f32x4 a[8], b[8], c[8];
    row_load_nt(src + (size_t)r * DM, lane, a);
    if (r + st < rows) row_load_nt(src + (size_t)(r + st) * DM, lane, b);
    for (;;) {
        if (r + 2 * st < rows) row_load_nt(src + (size_t)(r + 2 * st) * DM, lane, c);
        tab_fp4_row(a, dst, scl, r, lane); r += st; if (r >= rows) break;
        if (r + 2 * st < rows) row_load_nt(src + (size_t)(r + 2 * st) * DM, lane, a);
        tab_fp4_row(b, dst, scl, r, lane); r += st; if (r >= rows) break;
        if (r + 2 * st < rows) row_load_nt(src + (size_t)(r + 2 * st) * DM, lane, b);
        tab_fp4_row(c, dst, scl, r, lane); r += st; if (r >= rows) break;
    }
}
constexpr int EB = 4;
struct EBatch { v4u ur[EB], vr[EB]; float gg[EB], su[EB]; };
__device__ __forceinline__ void ebatch_load(EBatch& B, int e0, int e_lo, int e_hi, float g_lo, float g_hi, float s_lo, float s_hi, const unsigned char* U4, const unsigned char* V4, int lane, const int emask) {
#pragma unroll
    for (int q = 0; q < EB; ++q) { const int e = e0 + q; const int ei = __builtin_amdgcn_readlane(e < 64 ? e_lo : e_hi, e & 63) & emask;
        B.gg[q] = __builtin_bit_cast(float, __builtin_amdgcn_readlane(__builtin_bit_cast(int, e < 64 ? g_lo : g_hi), e & 63));
        B.su[q] = __builtin_bit_cast(float, __builtin_amdgcn_readlane(__builtin_bit_cast(int, e < 64 ? s_lo : s_hi), e & 63));
        B.ur[q] = *(const v4u*)(U4 + (size_t)ei * TROW + 16 * lane); B.vr[q] = *(const v4u*)(V4 + (size_t)ei * TROW + 16 * lane); }
}
__device__ __forceinline__ void ebatch_loadh(EBatch& B, int k, int ev, float gvv, float svv, const unsigned char* U4, const unsigned char* V4, int lane, const int emask) {
#pragma unroll
    for (int q = 0; q < EB; ++q) { const int e = k + q; const int ei = __builtin_amdgcn_readlane(ev, e) & emask;
        B.gg[q] = __builtin_bit_cast(float, __builtin_amdgcn_readlane(__builtin_bit_cast(int, gvv), e));
        B.su[q] = __builtin_bit_cast(float, __builtin_amdgcn_readlane(__builtin_bit_cast(int, svv), e));
        B.ur[q] = *(const v4u*)(U4 + (size_t)ei * TROW + 16 * lane); B.vr[q] = *(const v4u*)(V4 + (size_t)ei * TROW + 16 * lane); }
}
__device__ __forceinline__ float gelu_as(float v) {
    const float av = fabsf(v), t = __builtin_amdgcn_rcpf(av * 0.2316418882f + 1.0f);
    float q = t * 0.5307027145f + (-0.7265760135f); q = q * t + 0.7107068705f; q = q * t + (-0.142248368f); q = q * t + 0.127414796f; q = q * t;
    const float e = __builtin_amdgcn_exp2f((v * v) * (-0.72134752044f));
    const float m = v * (q * e);
    return v < 0.f ? m : v - m;
}
__device__ __forceinline__ float swap16_sum(float r) { auto p_ = __builtin_amdgcn_permlane16_swap(__builtin_bit_cast(unsigned, r), __builtin_bit_cast(unsigned, r), false, false); return __builtin_bit_cast(float, (unsigned)p_[0]) + __builtin_bit_cast(float, (unsigned)p_[1]); }
__device__ __forceinline__ float swap32_sum(float r) { auto p_ = __builtin_amdgcn_permlane32_swap(__builtin_bit_cast(unsigned, r), __builtin_bit_cast(unsigned, r), false, false); return __builtin_bit_cast(float, (unsigned)p_[0]) + __builtin_bit_cast(float, (unsigned)p_[1]); }
__device__ __forceinline__ void ebatch_compute(const EBatch& B, const f2v (&xf)[16], f2v (&acc)[16], const int lane) {
    static_assert(EB == 4, "the joint reduction below is written for four experts per batch");
    float s_[EB];
#pragma unroll
    for (int q = 0; q < EB; ++q) { f2v d2 = {0.f, 0.f};
#pragma unroll
        for (int j = 0; j < 4; ++j) {
            d2 += __builtin_amdgcn_cvt_scalef32_pk_f32_fp4(B.ur[q][j], 1.0f, 0) * xf[4 * j]; d2 += __builtin_amdgcn_cvt_scalef32_pk_f32_fp4(B.ur[q][j], 1.0f, 1) * xf[4 * j + 1];
            d2 += __builtin_amdgcn_cvt_scalef32_pk_f32_fp4(B.ur[q][j], 1.0f, 2) * xf[4 * j + 2]; d2 += __builtin_amdgcn_cvt_scalef32_pk_f32_fp4(B.ur[q][j], 1.0f, 3) * xf[4 * j + 3]; }
        s_[q] = d2.x + d2.y; }
    const bool b0 = (lane & 1) != 0, b1 = (lane & 2) != 0;
    const float u01 = b0 ? s_[0] : s_[1], u23 = b0 ? s_[2] : s_[3];
    const float r01 = (b0 ? s_[1] : s_[0]) + DPP_F(u01, 0xB1), r23 = (b0 ? s_[3] : s_[2]) + DPP_F(u23, 0xB1);
    const float u2 = b1 ? r01 : r23;
    float r = (b1 ? r23 : r01) + DPP_F(u2, 0x4E);
    r += DPP_F(r, 0x124); r += DPP_F(r, 0x128);
    r = swap16_sum(r); r = swap32_sum(r);
    float sa_ = b0 ? B.su[1] : B.su[0], sb_ = b0 ? B.su[3] : B.su[2]; asm volatile("" : "+v"(sa_), "+v"(sb_));
    const float suv = b1 ? sb_ : sa_;
    const float gv = gelu_as(r * suv);
#pragma unroll
    for (int q = 0; q < EB; ++q) {
        const float a = B.gg[q] * __builtin_bit_cast(float, __builtin_amdgcn_readlane(__builtin_bit_cast(int, gv), q)); const f2v a2 = {a, a};
#pragma unroll
        for (int j = 0; j < 4; ++j) {
            acc[4 * j] += a2 * __builtin_amdgcn_cvt_scalef32_pk_f32_fp4(B.vr[q][j], 1.0f, 0); acc[4 * j + 1] += a2 * __builtin_amdgcn_cvt_scalef32_pk_f32_fp4(B.vr[q][j], 1.0f, 1);
            acc[4 * j + 2] += a2 * __builtin_amdgcn_cvt_scalef32_pk_f32_fp4(B.vr[q][j], 1.0f, 2); acc[4 * j + 3] += a2 * __builtin_amdgcn_cvt_scalef32_pk_f32_fp4(B.vr[q][j], 1.0f, 3); } }
}
__device__ __forceinline__ void expert4_phase(const Frame& F, float* H, const bf16* XN, unsigned char* XN8, const unsigned char* U4, const unsigned char* V4, const int* EIDX, const float* GATE, const float* SU, const float* SV, const float* nw, const unsigned long long* SS, const bool dry) {
    const int lane = F.lane;
    const int emask = dry ? DBG_EMASK : 0xFFFFFF;
    int t = F.gw; if (t >= SEQ) return;
    int e_lo = EIDX[(size_t)t * 128 + lane], e_hi = EIDX[(size_t)t * 128 + 64 + lane];
    float g_lo = GATE[(size_t)t * 128 + lane] * SV[e_lo], g_hi = GATE[(size_t)t * 128 + 64 + lane] * SV[e_hi], s_lo = SU[e_lo] * ss_rstd(SS[t]), s_hi = SU[e_hi] * ss_rstd(SS[t]);
    EBatch A, B;
    ebatch_load(A, 0, e_lo, e_hi, g_lo, g_hi, s_lo, s_hi, U4, V4, lane, emask);
    for (;;) {
        const int tn = t + F.NGW; const bool more = tn < SEQ; const int tq = more ? tn : t;
        f2v xf[16];
#pragma unroll
        for (int j = 0; j < 4; ++j) { const v4u a = *(const v4u*)(XN + (size_t)t * DM + lane * 8 + 512 * j);
            xf[4 * j] = (f2v){bflo(a.x), bfhi(a.x)}; xf[4 * j + 1] = (f2v){bflo(a.y), bfhi(a.y)}; xf[4 * j + 2] = (f2v){bflo(a.z), bfhi(a.z)}; xf[4 * j + 3] = (f2v){bflo(a.w), bfhi(a.w)}; }
        const int ne_lo = EIDX[(size_t)tq * 128 + lane], ne_hi = EIDX[(size_t)tq * 128 + 64 + lane];
        const float ng_lo = GATE[(size_t)tq * 128 + lane] * SV[ne_lo], ng_hi = GATE[(size_t)tq * 128 + 64 + lane] * SV[ne_hi], ns_lo = SU[ne_lo] * ss_rstd(SS[tq]), ns_hi = SU[ne_hi] * ss_rstd(SS[tq]);
        f2v acc[16];
#pragma unroll
        for (int i = 0; i < 16; ++i) acc[i] = (f2v){0.f, 0.f};
#pragma unroll
        for (int hf = 0; hf < 2; ++hf) {
            const int ev = hf ? e_hi : e_lo; const float gvv = hf ? g_hi : g_lo, svv = hf ? s_hi : s_lo;
#pragma unroll 1
            for (int k = 0; k < 64; k += 2 * EB) {
                ebatch_loadh(B, k + EB, ev, gvv, svv, U4, V4, lane, emask);
                ebatch_compute(A, xf, acc, lane);
                if (k + 2 * EB < 64) ebatch_loadh(A, k + 2 * EB, ev, gvv, svv, U4, V4, lane, emask);
                else if (hf == 0) ebatch_loadh(A, 0, e_hi, g_hi, s_hi, U4, V4, lane, emask);
                else ebatch_loadh(A, 0, ne_lo, ng_lo, ns_lo, U4, V4, lane, emask);
                ebatch_compute(B, xf, acc, lane);
            } }
        f32x4 hv[8]; row_load(H + (size_t)t * DM, lane, hv);
#pragma unroll
        for (int j = 0; j < 8; ++j) { hv[j][0] += acc[2 * j].x; hv[j][1] += acc[2 * j].y; hv[j][2] += acc[2 * j + 1].x; hv[j][3] += acc[2 * j + 1].y; }
#pragma unroll
        for (int j = 0; j < 4; ++j) { if (!dry) { *(f32x4*)(H + (size_t)t * DM + lane * 8 + 512 * j) = hv[2 * j]; *(f32x4*)(H + (size_t)t * DM + lane * 8 + 512 * j + 4) = hv[2 * j + 1]; } }
        const float rstd = row_rstd(hv);
        if (!dry) row_store_norm8(hv, rstd, nw, XN8 + (size_t)t * DM, lane);
        if (!more) break;
        t = tn; e_lo = ne_lo; e_hi = ne_hi; g_lo = ng_lo; g_hi = ng_hi; s_lo = ns_lo; s_hi = ns_hi;
    }
}
}
#define XB_TMO      128
#define XB_XCNT(j)  (256  + 64 * (j))
#define XB_XSUB(j)  (1280 + 64 * (j))
#define XB_XGEN(j)  (2304 + 64 * (j))
#define XB_TOP      3328
#define XB_TOPGEN   3392
#define XCD_BAR_WORDS 3456
#define XB_SPIN_CAP (1u << 22)
__device__ __forceinline__ unsigned xb_ld(unsigned* p)              { return __hip_atomic_load(p, __ATOMIC_RELAXED, __HIP_MEMORY_SCOPE_AGENT); }
__device__ __forceinline__ unsigned xb_add(unsigned* p, unsigned v) { return __hip_atomic_fetch_add(p, v, __ATOMIC_RELAXED, __HIP_MEMORY_SCOPE_AGENT); }
__device__ __forceinline__ unsigned xb_xcc_id() { return (unsigned)__builtin_amdgcn_s_getreg((3 << 11) | 20) & 0xFu; }
#define XB_SPIN(cond, bar) do { unsigned _sp = 0; while (cond) { __builtin_amdgcn_s_sleep(1); \
    if ((++_sp & 255u) == 0u) { if (xb_ld(&(bar)[XB_TMO])) break; if (_sp > XB_SPIN_CAP) { atomicAdd(&(bar)[XB_TMO], 1u); break; } } } } while (0)
struct XcdBarrier { unsigned* bar; unsigned x; volatile LAS unsigned* st; };
__device__ __forceinline__ XcdBarrier xcd_barrier_post(unsigned* bar, volatile LAS unsigned* st, const int tid) {
    XcdBarrier b; b.bar = bar; b.x = xb_xcc_id(); b.st = st;
    if (tid == 0) (void)xb_add(&bar[XB_XCNT(b.x)], 1u);
    return b;
}
__device__ __forceinline__ void xcd_barrier_complete(unsigned* bar, unsigned x, unsigned& nloc, unsigned& nx) {
    const unsigned G = gridDim.x * gridDim.y * gridDim.z;
    unsigned sum, cnt, mine, sp = 0u;
    for (;;) {
        sum = 0u; cnt = 0u; mine = 0u;
#pragma unroll
        for (unsigned j = 0; j < 16; ++j) { const unsigned c = xb_ld(&bar[XB_XCNT(j)]); sum += c; cnt += (c > 0u) ? 1u : 0u; mine = (j == x) ? c : mine; }
        if (sum == G) break;
        __builtin_amdgcn_s_sleep(1);
        if ((++sp & 255u) == 0u) { if (xb_ld(&bar[XB_TMO])) break; if (sp > XB_SPIN_CAP) { atomicAdd(&bar[XB_TMO], 1u); break; } }
    }
    nloc = mine > 0u ? mine : 1u; nx = cnt > 0u ? cnt : 1u;
}
__device__ __forceinline__ void xcd_barrier(const XcdBarrier& b, const int tid) {
    asm volatile("s_waitcnt vmcnt(0)" ::: "memory");
    __syncthreads();
    if (tid == 0) {
        unsigned* bar = b.bar;
        __builtin_amdgcn_s_waitcnt(0);
        unsigned nloc = b.st[0], nx = b.st[1];
        if (nloc == 0u) { xcd_barrier_complete(bar, b.x, nloc, nx); b.st[0] = nloc; b.st[1] = nx; }
        const unsigned old = xb_add(&bar[XB_XSUB(b.x)], 1u);
        const unsigned gen = old / nloc;
        if (old + 1u == (gen + 1u) * nloc) {
            __builtin_amdgcn_fence(__ATOMIC_RELEASE, "agent");
            asm volatile("s_waitcnt vmcnt(0)" ::: "memory");
            const unsigned og = xb_add(&bar[XB_TOP], 1u);
            const unsigned tg = og / nx;
            if (og + 1u == (tg + 1u) * nx) xb_add(&bar[XB_TOPGEN], 1u);
            else XB_SPIN(xb_ld(&bar[XB_TOPGEN]) == tg, bar);
            __builtin_amdgcn_fence(__ATOMIC_ACQUIRE, "agent");
            xb_add(&bar[XB_XGEN(b.x)], 1u);
            asm volatile("s_waitcnt vmcnt(0)" ::: "memory");
        } else {
            XB_SPIN(xb_ld(&bar[XB_XGEN(b.x)]) == gen, bar);
            __builtin_amdgcn_fence(__ATOMIC_ACQUIRE, "agent");
            asm volatile("s_waitcnt vmcnt(0)" ::: "memory");
        }
    }
    __syncthreads();
}

constexpr int NWAVES = 8;
constexpr int RING_BYTES = 131072, LDSCTL_OFF = RING_BYTES, MISC_OFF = LDSCTL_OFF + 320, LDS_BYTES = 147456;
constexpr int NPH = 25;
struct Args { const float* in[27]; float* out; unsigned char* ws; int ph_lo, ph_hi, dry, pad; };

__device__ __forceinline__ fox::BlockRef fox_ref(int L, int pass, const bf16* Q, const bf16* K, const bf16* V, bf16* O) {
    const int hd = L >> 4, x = L & 15, qb = pass ? 31 - x : x;
    fox::BlockRef r; r.Q = Q + (size_t)qb * fox::QB * fox::RS + hd * fox::D; r.O = O + (size_t)qb * fox::QB * fox::RS + hd * fox::D;
    r.K = K + hd * fox::D; r.V = V + hd * fox::D; r.P0 = qb * fox::QB; return r;
}

__device__ __forceinline__ void run_gemm_fin(const Frame& F, const bf16* A, const bf16* Bt, int N, int K, const pg8::EpiFin& E) {
    LAS unsigned char* lds = F.lds; const int G = F.G;
    asm volatile("" : "+s"(K), "+s"(N));
    pg8::Gemm g{A, Bt, SEQ, N, K}; pg8::StaticOrder S; S.init(SEQ, N, G, F.bx);
    pg8::gemm_phase<pg8::EpiFin, pg8::StaticOrder, true, true, true>(lds, g, S, E, F.tid);
}
template <int MODE, bool FP8 = false>
__device__ __forceinline__ void run_gemm(const Frame& F, const bf16* A, const bf16* Bt, int N, int K, const pg8::EpiG<MODE>& E) {
    LAS unsigned char* lds = F.lds; const int G = F.G;
    asm volatile("" : "+s"(K), "+s"(N));
    pg8::Gemm g{A, Bt, SEQ, N, K}; pg8::StaticOrder S; S.init(SEQ, N, G, F.bx);
    pg8::gemm_phase<pg8::EpiG<MODE>, pg8::StaticOrder, true, true, FP8>(lds, g, S, E, F.tid);
}

__device__ __forceinline__ int lane_id_() { unsigned m = ~0u; asm volatile("" : "+s"(m)); return (int)__builtin_amdgcn_mbcnt_hi(m, __builtin_amdgcn_mbcnt_lo(m, 0u)); }
__device__ __forceinline__ Frame mkframe(unsigned char* lds_raw, int wave_s) {
    Frame F; F.lds = (LAS unsigned char*)lds_raw;
    int bx_ = blockIdx.x; asm volatile("" : "+s"(bx_), "+s"(wave_s));
    F.wave = wave_s; F.lane = lane_id_(); F.tid = wave_s * 64 + F.lane; F.bx = bx_;
    F.G = gridDim.x; { const int bx = bx_; F.vcu = (F.G % 8 == 0) ? (bx % 8) * (F.G / 8) + bx / 8 : bx; }
    F.gw = F.vcu * NWAVES + F.wave; F.NGW = F.G * NWAVES; F.gt = F.vcu * (NWAVES * 64) + F.tid; F.NGT = F.G * NWAVES * 64;
    return F;
}
#define PHASE_BEGIN const __attribute__((address_space(4))) Args* ap = (const __attribute__((address_space(4))) Args*)__builtin_amdgcn_kernarg_segment_ptr(); asm volatile("" : "+s"(ap)); unsigned char* const ws = ap->ws; const Frame F = mkframe(lds_raw, wave_s); (void)ws; (void)F
#define INP(k) (ap->in[k])
#define WSP(T, off) ((T*)(ws + (off)))
constexpr size_t TABN = (size_t)NEXP * DM;

__global__ void __launch_bounds__(NWAVES * 64, 2) yoco_fwd(Args args) {
    extern __shared__ __attribute__((aligned(16))) unsigned char lds_raw[];
    const int wave_s = __builtin_amdgcn_readfirstlane((int)threadIdx.x >> 6);
    { LAS unsigned* z = (LAS unsigned*)((LAS unsigned char*)lds_raw + LDSCTL_OFF); for (int u = wave_s * 64 + lane_id_(); u < (LDS_BYTES - LDSCTL_OFF) / 4; u += NWAVES * 64) z[u] = 0u; }
    __syncthreads();
    const int lo = args.ph_lo, hi = args.ph_hi;
    XcdBarrier bar; bar.bar = (unsigned*)(args.ws + WS_CTL) + CW_BAR; bar.x = 0; bar.st = (volatile LAS unsigned*)((LAS unsigned char*)lds_raw + MISC_OFF) + 8;
    if (hi - lo > 1) bar = xcd_barrier_post(bar.bar, bar.st, wave_s * 64 + lane_id_());
#ifdef ONLY_PH
#define IN(k) ((k) == ONLY_PH)
#elif defined(PHMASK)
#define IN(k) (((PHMASK >> (k)) & 1) && lo <= (k) && (k) < hi)
#else
#define IN(k) (lo <= (k) && (k) < hi)
#endif
#define PH(k) if (IN(k))
#define RBAR(k) const bool dry = ap->dry != 0; (void)dry
#define SEAM(k) do { if (IN(k) && IN((k) + 1)) xcd_barrier(bar, wave_s * 64 + lane_id_()); } while (0)

    PH(0) { PHASE_BEGIN; RBAR(0);
        LAS float* scr = (LAS float*)(F.lds + F.wave * 16384);
        constexpr int I_IN = 32 * 322, I_OUT = 64 * 64, I_KV = 32 * 128, I_SQ = 32 * 64, I_EP = 4 * 64;
        constexpr int NITEMS = I_IN + I_OUT + I_KV + 6 * I_SQ + 2 * I_EP;
        auto decode = [&](int r) -> P0Item {
            if (r < I_IN) return P0Item{INP(3), (unsigned char*)WSP(bf16, WS_WIN), 2048, DINP, DINP, r, 0}; r -= I_IN;
            if (r < I_OUT) return P0Item{INP(10), (unsigned char*)WSP(bf16, WS_WOUT), 4096, 2048, 2048, r, 0}; r -= I_OUT;
            if (r < I_KV) return P0Item{INP(12), WSP(unsigned char, WS_WKV), 2048, 4096, 4112, r, 1}; r -= I_KV;
            if (r < I_SQ) return P0Item{INP(15), WSP(unsigned char, WS_WQ), 2048, 2048, 2048, r, 1}; r -= I_SQ;
            if (r < I_SQ) return P0Item{INP(16), (unsigned char*)WSP(bf16, WS_WO), 2048, 2048, 2048, r, 0}; r -= I_SQ;
            if (r < 2 * I_SQ) { const int l = r / I_SQ; return P0Item{INP(18) + (size_t)l * 2048 * 2048, (unsigned char*)(WSP(bf16, WS_WCQ) + (size_t)l * 2048 * 2048), 2048, 2048, 2048, r % I_SQ, 0}; } r -= 2 * I_SQ;
            if (r < 2 * I_SQ) { const int l = r / I_SQ; return P0Item{INP(23) + (size_t)l * 2048 * 2048, WSP(unsigned char, WS_WEG) + (size_t)l * 2048 * 2048, 2048, 2048, 2048, r % I_SQ, 1}; } r -= 2 * I_SQ;
            { const int l = r / I_EP; return P0Item{INP(25) + (size_t)l * 256 * 2048, (unsigned char*)(WSP(bf16, WS_WEP) + (size_t)l * 2048 * 256), 256, 2048, 2048, r % I_EP, 0}; }
        };
        { int it = F.gw;
          if (it < NITEMS) {
            float ta[32], tb[32]; P0Item I0 = decode(it), I1 = I0;
            p0_load(I0, F.lane, ta);
            for (;;) {
                const int i1 = it + F.NGW; const bool h1 = i1 < NITEMS;
                if (h1) { I1 = decode(i1); p0_load(I1, F.lane, tb); }
                p0_emit(I0, F.lane, ta, scr);
                if (!h1) break;
                const int i2 = i1 + F.NGW; const bool h2 = i2 < NITEMS;
                if (h2) { I0 = decode(i2); p0_load(I0, F.lane, ta); }
                p0_emit(I1, F.lane, tb, scr);
                if (!h2) break;
                it = i2;
            } } }
        kvnorm_pack(F, INP(12), WSP(f32x4, WS_WFP));
        cvt_f32_bf16(F, INP(19), WSP(bf16, WS_SK), (size_t)2 * PH * 2 * NKEY * 128 / 8);
        cvt_f32_bf16(F, INP(1), WSP(bf16, WS_PBF), (size_t)2 * SEQ * PLE / 8);
        norm_phase<true>(F, INP(0), INP(2), WSP(bf16, WS_XN));
    }
    SEAM(0);
    PH(1) { PHASE_BEGIN; RBAR(1);
        { pg8::EpiG<pg8::EP_INPROJ> E{WSP(bf16, WS_Z), WSP(bf16, WS_XBC), WSP(float, WS_DT), nullptr, nullptr, 0}; run_gemm<pg8::EP_INPROJ>(F, WSP(bf16, WS_XN), WSP(bf16, WS_WIN), 10240, 2048, E); }
    }
    PH(1) { PHASE_BEGIN; RBAR(1);
#pragma unroll 1
        for (int l = 0; l < 2; ++l) { pg8::EpiG<pg8::EP_BF16> E{WSP(bf16, WS_PP) + (size_t)l * SEQ * DM, nullptr, nullptr, nullptr, nullptr, DM, INP(24)  }; run_gemm<pg8::EP_BF16>(F, WSP(bf16, WS_PBF) + (size_t)l * SEQ * PLE, WSP(bf16, WS_WEP) + (size_t)l * 2048 * 256, DM, PLE, E); }
        for (int u = F.vcu; u < SEQ / 32; u += F.G) dt_unit(F.lds, u, WSP(bf16, WS_XN), WSP(bf16, WS_WIN) + (size_t)10240 * 2048, WSP(float, WS_DT), F.tid);
    }
    SEAM(1);
    PH(2) { PHASE_BEGIN; RBAR(2);
        for (int u = F.vcu; u < NCH * NG; u += F.G) { const int c = u >> 3, g = u & 7;
            { const Frame Fa = mkframe(lds_raw, wave_s); if (!dry) acum8_unit(Fa, c, g, WSP(float, WS_DT), INP(6), INP(7), WSP(float, WS_ACL)); }
            { const Frame Fc = mkframe(lds_raw, wave_s); conv_unit(Fc, c, g, WSP(bf16, WS_XBC), INP(4), INP(5), WSP(bf16, WS_XBCC)); }
            asm volatile("s_waitcnt vmcnt(0)" ::: "memory"); __syncthreads();
            ssd::s1_unit(F.lds, c, g, WSP(bf16, WS_XBCC), WSP(float, WS_DT), WSP(float, WS_ACL), WSP(float, WS_SLOC), wave_s * 64 + lane_id_());
        }
    }
    SEAM(3);
    PH(4) { PHASE_BEGIN; RBAR(4); ssd::s2_phase(F, WSP(float, WS_SLOC), WSP(float, WS_ACL), WSP(bf16, WS_SIN)); }
    SEAM(4);
    PH(5) { PHASE_BEGIN; RBAR(5); for (int u = F.vcu; u < NCH * NG; u += F.G) ssd::s3p_unit(F.lds, u >> 3, u & 7, WSP(bf16, WS_XBCC), WSP(float, WS_DT), WSP(float, WS_ACL), WSP(bf16, WS_SIN), INP(8), WSP(bf16, WS_Y), F.tid, dry ? DBG_S3MODE : 0); }
    SEAM(5);
    PH(6) { PHASE_BEGIN; RBAR(6);
        gnorm_phase(F, WSP(bf16, WS_Y), WSP(bf16, WS_Z), INP(9), dry);
    }
    SEAM(6);
    PH(7) { PHASE_BEGIN; RBAR(7); pg8::EpiG<pg8::EP_RESX> E{WSP(bf16, WS_XN), nullptr, WSP(float, WS_H), INP(0), nullptr, (DBG_SKIP & 1), INP(17), (unsigned long long*)((unsigned*)(ws + WS_CTL) + CW_ROWSS)}; run_gemm<pg8::EP_RESX>(F, WSP(bf16, WS_Y), WSP(bf16, WS_WOUT), DM, DI, E); }
    SEAM(7);
    { constexpr int l = 0, pb = 8;
        PH(pb + 1) { PHASE_BEGIN; RBAR(pb + 1); pg8::EpiG<pg8::EP_BF16S> E{WSP(bf16, WS_PQ), nullptr, nullptr, nullptr, nullptr, DM, nullptr, (unsigned long long*)((unsigned*)(ws + WS_CTL) + CW_ROWSS) + l * SEQ}; run_gemm<pg8::EP_BF16S>(F, WSP(bf16, WS_XN), WSP(bf16, WS_WCQ) + (size_t)l * 2048 * 2048, DM, DM, E); }
        if (gridDim.x != 256) SEAM(pb + 1); else if (IN(pb + 1) && IN(pb + 2)) { asm volatile("s_waitcnt vmcnt(0)" ::: "memory"); __syncthreads(); }
        PH(pb + 2) { PHASE_BEGIN; RBAR(pb + 2);
            if (gridDim.x == 256) { const Frame Fs = mkframe(lds_raw, wave_s);
              peer::TabStream TS{INP(20), INP(21) + (size_t)l * TABN, WSP(unsigned char, WS_TAB), WSP(unsigned char, WS_TAB) + (size_t)l * TABN + 1024, WSP(float, WS_TSC), WSP(float, WS_TSC) + (2 + l) * NEXP, Fs.gw};
              const int w2_ = (Fs.bx & 7) * 32 + (Fs.bx >> 3), upm = (w2_ >> 6) * 8 + (w2_ & 7), upn = (w2_ & 63) >> 3;
              peer::topk2_unit<(l == 0) ? 16 : 8>(Fs.lds + Fs.wave * 1024, upm * 8 + Fs.wave, upn, WSP(bf16, WS_PQ), WSP(bf16, WS_SK) + (size_t)l * PH * 2 * NKEY * 128, WSP(int, WS_EIDX), WSP(float, WS_GATE), TS);
            } else {
#pragma unroll 1
              for (int step = 0; step < 2; ++step) {
                const Frame Fs = mkframe(lds_raw, wave_s);
                if ((step == 0) == ((wave_s & 1) != 0)) { peer::TabStream T0{}; for (int u = Fs.gw; u < (SEQ / 32) * PH; u += Fs.NGW) peer::topk2_unit<0>(Fs.lds + Fs.wave * 1024, u & 255, u >> 8, WSP(bf16, WS_PQ), WSP(bf16, WS_SK) + (size_t)l * PH * 2 * NKEY * 128, WSP(int, WS_EIDX), WSP(float, WS_GATE), T0); }
                else { if (l == 0) peer::tab_fp4_phase(Fs, INP(20) + (size_t)l * TABN, WSP(unsigned char, WS_TAB) + (size_t)l * TABN, WSP(float, WS_TSC) + l * NEXP, NEXP);
                       peer::tab_fp4_phase(Fs, INP(21) + (size_t)l * TABN, WSP(unsigned char, WS_TAB) + (size_t)l * TABN + 1024, WSP(float, WS_TSC) + (2 + l) * NEXP, NEXP); } } } }
        SEAM(pb + 2);
        PH(pb + 3) { PHASE_BEGIN; RBAR(pb + 3); peer::expert4_phase(F, WSP(float, WS_H), WSP(bf16, WS_XN), WSP(unsigned char, WS_XN2), WSP(unsigned char, WS_TAB) + (size_t)l * TABN, WSP(unsigned char, WS_TAB) + (size_t)l * TABN + 1024, WSP(int, WS_EIDX), WSP(float, WS_GATE), WSP(float, WS_TSC) + l * NEXP, WSP(float, WS_TSC) + (2 + l) * NEXP, INP(22) + l * DM, (const unsigned long long*)((const unsigned*)(ws + WS_CTL) + CW_ROWSS) + l * SEQ, dry); }
        SEAM(pb + 3);
        PH(pb + 4) { PHASE_BEGIN; RBAR(pb + 4); pg8::EpiG<pg8::EP_PLE> E{nullptr, nullptr, WSP(float, WS_H), INP(24) + l * DM, WSP(bf16, WS_PP) + (size_t)l * SEQ * DM, (DBG_SKIP & (l ? 32 : 4)) | (int)dry}; run_gemm<pg8::EP_PLE, true>(F, (const bf16*)WSP(unsigned char, WS_XN2), (const bf16*)(WSP(unsigned char, WS_WEG) + (size_t)l * 2048 * 2048), DM, DM, E); }
        SEAM(pb + 4);
    }
        PH(13) { PHASE_BEGIN; RBAR(13);
            kvnorm_stage(F, WSP(f32x4, WS_WFP));
#pragma unroll 1
            for (int step = 0; step < 2; ++step) {
                const Frame Fs = mkframe(lds_raw, wave_s);
                if ((step == 0) == ((wave_s & 1) != 0)) { if (!dry) peer::tab_fp4_phase(Fs, INP(20) + TABN, WSP(unsigned char, WS_TAB) + TABN, WSP(float, WS_TSC) + NEXP, NEXP); }
                else kvnorm_rows(Fs, WSP(float, WS_H), INP(11), INP(14), INP(13), WSP(unsigned char, WS_XN), WSP(unsigned char, WS_XN2), WSP(float, WS_LOGF)); }
            __syncthreads(); }
        SEAM(13);
        PH(14) { PHASE_BEGIN; RBAR(14);
            for (int f = F.bx; f < FH; f += F.G) cumsum_unit(F, f, WSP(float, WS_LOGF), WSP(float, WS_NB));
            { pg8::EpiG<pg8::EP_KV> E{WSP(bf16, WS_K), WSP(bf16, WS_V), nullptr, nullptr, nullptr, 0}; run_gemm<pg8::EP_KV, true>(F, (const bf16*)WSP(unsigned char, WS_XN), (const bf16*)WSP(unsigned char, WS_WKV), 4096, DM, E); }
            if (gridDim.x == 256) {
                asm volatile("s_waitcnt vmcnt(0)" ::: "memory"); __syncthreads();
#pragma unroll 1
                for (int i = 0; i < 2; ++i) { const int L = i * 256 + F.bx, w2_ = (L & 7) * 64 + (L >> 3), upm = (w2_ >> 7) * 8 + (w2_ & 7), upn = (w2_ & 127) >> 3;
                    if (upn < 8) qknorm_tile(F, WSP(bf16, WS_K), upm, upn, (unsigned*)(ws + WS_CTL) + CW_NORM + 16); } }
        }
        PH(14) { PHASE_BEGIN; RBAR(14);
            { pg8::EpiG<pg8::EP_BF16> E{WSP(bf16, WS_Q), nullptr, nullptr, nullptr, nullptr, DM}; run_gemm<pg8::EP_BF16, true>(F, (const bf16*)WSP(unsigned char, WS_XN2), (const bf16*)WSP(unsigned char, WS_WQ), DM, DM, E); }
            if (gridDim.x == 256) { asm volatile("s_waitcnt vmcnt(0)" ::: "memory"); __syncthreads();
                const int w2_ = (F.bx & 7) * 32 + (F.bx >> 3), upm = (w2_ >> 6) * 8 + (w2_ & 7), upn = (w2_ & 63) >> 3;
                qknorm_tile(F, WSP(bf16, WS_Q), upm, upn, (unsigned*)(ws + WS_CTL) + CW_NORM); }
        }
        SEAM(14);
        if (gridDim.x != 256) {
        PH(15) { PHASE_BEGIN; RBAR(15); qknorm_phase(F, WSP(bf16, WS_Q), WSP(bf16, WS_K), (unsigned*)(ws + WS_CTL) + CW_NORM); }
        SEAM(15);
        }
        PH(16) { PHASE_BEGIN; RBAR(16);
            fox::ItemQ iq; iq.tick = (unsigned*)(ws + WS_CTL) + CW_TICKET + (dry ? 1024 : 0); iq.bc = (volatile LAS unsigned*)(F.lds + MISC_OFF) + 16; iq.NB = WSP(float, WS_NB);
            iq.NORM = (const unsigned*)(ws + WS_CTL) + CW_NORM; iq.Q = WSP(bf16, WS_Q); iq.K = WSP(bf16, WS_K); iq.V = WSP(bf16, WS_V); iq.O = WSP(bf16, WS_O); iq.OP = WSP(bf16, WS_OP); iq.ML = WSP(float, WS_ML); iq.xq = F.vcu >> 5;
#define FOX_NBLOAD(it) do { LAS f32x4* nbl_ = (LAS f32x4*)(F.lds + fox::LDS_BYTES); const f32x4* src_ = (const f32x4*)(iq.NB + (size_t)fox::item_head(it) * SEQ); \
                unsigned i0_ = (unsigned)(wave_s * 64 + lane_id_()); asm volatile("" : "+v"(i0_)); \
                _Pragma("unroll") for (unsigned k_ = 0; k_ < SEQ / 4 / (NWAVES * 64); ++k_) nbl_[i0_ + k_ * NWAVES * 64] = src_[i0_ + k_ * NWAVES * 64]; } while (0)
            int it = fox::q_pull(iq, F.tid);
            if (it < fox::NITEM) {
                fox::Seam S; fox::BlockRef cur = fox::q_ref(iq, it, F.lane), nxt;
                FOX_NBLOAD(it);
                fox::causal_prime(cur, (char*)lds_raw, S, wave_s * 64 + lane_id_());
                for (;;) {
                    int itn;
                    fox::causal_block(cur, nxt, itn, iq, SEQ, (char*)lds_raw, S, wave_s * 64 + lane_id_());
                    if (itn >= fox::NITEM) break;
                    if (fox::item_head(itn) != fox::item_head(it)) { FOX_NBLOAD(itn); __syncthreads(); }
                    cur = nxt; it = itn;
                }
            }
#undef FOX_NBLOAD
        }
        SEAM(16);
        PH(17) { PHASE_BEGIN; RBAR(17); attn_combine_phase(F, WSP(bf16, WS_O), WSP(bf16, WS_OP), WSP(float, WS_ML)); }
        SEAM(17);
        PH(18) { PHASE_BEGIN; RBAR(18); pg8::EpiG<pg8::EP_RESH> E{WSP(bf16, WS_XN), nullptr, WSP(float, WS_H), nullptr, nullptr, (int)dry, INP(17) + DM, (unsigned long long*)((unsigned*)(ws + WS_CTL) + CW_ROWSS) + SEQ}; run_gemm<pg8::EP_RESH>(F, WSP(bf16, WS_O), WSP(bf16, WS_WO), DM, DM, E); }
        SEAM(18);
    { constexpr int l = 1, pb = 19;
        PH(pb + 1) { PHASE_BEGIN; RBAR(pb + 1); pg8::EpiG<pg8::EP_BF16S> E{WSP(bf16, WS_PQ), nullptr, nullptr, nullptr, nullptr, DM, nullptr, (unsigned long long*)((unsigned*)(ws + WS_CTL) + CW_ROWSS) + l * SEQ}; run_gemm<pg8::EP_BF16S>(F, WSP(bf16, WS_XN), WSP(bf16, WS_WCQ) + (size_t)l * 2048 * 2048, DM, DM, E); }
        if (gridDim.x != 256) SEAM(pb + 1); else if (IN(pb + 1) && IN(pb + 2)) { asm volatile("s_waitcnt vmcnt(0)" ::: "memory"); __syncthreads(); }
        PH(pb + 2) { PHASE_BEGIN; RBAR(pb + 2);
            if (gridDim.x == 256) { const Frame Fs = mkframe(lds_raw, wave_s);
              peer::TabStream TS{INP(20), INP(21) + (size_t)l * TABN, WSP(unsigned char, WS_TAB), WSP(unsigned char, WS_TAB) + (size_t)l * TABN + 1024, WSP(float, WS_TSC), WSP(float, WS_TSC) + (2 + l) * NEXP, Fs.gw};
              const int w2_ = (Fs.bx & 7) * 32 + (Fs.bx >> 3), upm = (w2_ >> 6) * 8 + (w2_ & 7), upn = (w2_ & 63) >> 3;
              peer::topk2_unit<(l == 0) ? 16 : 8>(Fs.lds + Fs.wave * 1024, upm * 8 + Fs.wave, upn, WSP(bf16, WS_PQ), WSP(bf16, WS_SK) + (size_t)l * PH * 2 * NKEY * 128, WSP(int, WS_EIDX), WSP(float, WS_GATE), TS);
            } else {
#pragma unroll 1
              for (int step = 0; step < 2; ++step) {
                const Frame Fs = mkframe(lds_raw, wave_s);
                if ((step == 0) == ((wave_s & 1) != 0)) { peer::TabStream T0{}; for (int u = Fs.gw; u < (SEQ / 32) * PH; u += Fs.NGW) peer::topk2_unit<0>(Fs.lds + Fs.wave * 1024, u & 255, u >> 8, WSP(bf16, WS_PQ), WSP(bf16, WS_SK) + (size_t)l * PH * 2 * NKEY * 128, WSP(int, WS_EIDX), WSP(float, WS_GATE), T0); }
                else { if (l == 0) peer::tab_fp4_phase(Fs, INP(20) + (size_t)l * TABN, WSP(unsigned char, WS_TAB) + (size_t)l * TABN, WSP(float, WS_TSC) + l * NEXP, NEXP);
                       peer::tab_fp4_phase(Fs, INP(21) + (size_t)l * TABN, WSP(unsigned char, WS_TAB) + (size_t)l * TABN + 1024, WSP(float, WS_TSC) + (2 + l) * NEXP, NEXP); } } } }
        SEAM(pb + 2);
        PH(pb + 3) { PHASE_BEGIN; RBAR(pb + 3); peer::expert4_phase(F, WSP(float, WS_H), WSP(bf16, WS_XN), WSP(unsigned char, WS_XN2), WSP(unsigned char, WS_TAB) + (size_t)l * TABN, WSP(unsigned char, WS_TAB) + (size_t)l * TABN + 1024, WSP(int, WS_EIDX), WSP(float, WS_GATE), WSP(float, WS_TSC) + l * NEXP, WSP(float, WS_TSC) + (2 + l) * NEXP, INP(22) + l * DM, (const unsigned long long*)((const unsigned*)(ws + WS_CTL) + CW_ROWSS) + l * SEQ, dry); }
        SEAM(pb + 3);
        if (gridDim.x == 256) {
            PH(pb + 4) { PHASE_BEGIN; RBAR(pb + 4); unsigned* cw = (unsigned*)(ws + WS_CTL);
                pg8::EpiFin E{WSP(float, WS_H), INP(24) + l * DM, WSP(bf16, WS_PP) + (size_t)l * SEQ * DM, INP(26), (unsigned long long*)(cw + CW_FINSS), cw + CW_FINCNT, ap->out, (int)dry};
                run_gemm_fin(F, (const bf16*)WSP(unsigned char, WS_XN2), (const bf16*)(WSP(unsigned char, WS_WEG) + (size_t)l * 2048 * 2048), DM, DM, E); }
        } else {
            PH(pb + 4) { PHASE_BEGIN; RBAR(pb + 4); pg8::EpiG<pg8::EP_PLE> E{nullptr, nullptr, WSP(float, WS_H), INP(24) + l * DM, WSP(bf16, WS_PP) + (size_t)l * SEQ * DM, (DBG_SKIP & (l ? 32 : 4)) | (int)dry}; run_gemm<pg8::EP_PLE, true>(F, (const bf16*)WSP(unsigned char, WS_XN2), (const bf16*)(WSP(unsigned char, WS_WEG) + (size_t)l * 2048 * 2048), DM, DM, E); }
            SEAM(pb + 4);
            PH(24) { PHASE_BEGIN; RBAR(24); final_norm_phase(F, WSP(float, WS_H), INP(26), ap->out); }
        }
    }
#undef IN
#undef SEAM
}

extern "C" void kernel_launch(void* const* d_in, const int* in_sizes, int n_in, void* d_out, int out_size, void* d_ws, size_t ws_size, hipStream_t stream) {
    static int grid = 0;
    if (grid == 0) {
        if (n_in != 27 || out_size != SEQ * DM || ws_size < WS_END) { fprintf(stderr, "kernel_launch: expected 27 inputs, out %d, ws >= %zu; got n_in %d out %d ws %zu\n", SEQ * DM, (size_t)WS_END, n_in, out_size, ws_size); grid = -1; return; }
        int dev = 0, cus = 0, per_cu = 0;
        if (hipGetDevice(&dev) != hipSuccess || hipDeviceGetAttribute(&cus, hipDeviceAttributeMultiprocessorCount, dev) != hipSuccess) { fprintf(stderr, "kernel_launch: device query failed\n"); grid = -1; return; }
        if (hipFuncSetAttribute((const void*)yoco_fwd, hipFuncAttributeMaxDynamicSharedMemorySize, LDS_BYTES) != hipSuccess) { fprintf(stderr, "kernel_launch: hipFuncSetAttribute failed\n"); grid = -1; return; }
        if (hipOccupancyMaxActiveBlocksPerMultiprocessor(&per_cu, (const void*)yoco_fwd, NWAVES * 64, LDS_BYTES) != hipSuccess || per_cu < 1) { fprintf(stderr, "kernel_launch: occupancy query says %d blocks/CU\n", per_cu); (void)hipGetLastError(); }
        grid = cus;
    }
    if (grid < 0) return;
    if (hipMemsetAsync((char*)d_ws + WS_CTL, 0, CTL_ZERO_BYTES, stream) != hipSuccess) { fprintf(stderr, "kernel_launch: memset failed\n"); return; }
    Args a{};
    for (int i = 0; i < 27; ++i) a.in[i] = (const float*)d_in[i];
    a.out = (float*)d_out; a.ws = (unsigned char*)d_ws;
#if MK_PER_PHASE
    for (int ph = 0; ph < NPH; ++ph) { a.ph_lo = ph; a.ph_hi = ph + 1;
        for (int rep = 0; rep < DBG_NREP; ++rep) if (ph == DBG_REPEAT) { a.dry = 1; hipLaunchKernelGGL(yoco_fwd, dim3(grid), dim3(NWAVES * 64), LDS_BYTES, stream, a); a.dry = 0; }
        hipLaunchKernelGGL(yoco_fwd, dim3(grid), dim3(NWAVES * 64), LDS_BYTES, stream, a); }
#else
    a.ph_lo = 0; a.ph_hi = NPH;
    void* kargs[] = {&a};
    hipError_t e = hipLaunchCooperativeKernel((const void*)yoco_fwd, dim3(grid), dim3(NWAVES * 64), kargs, LDS_BYTES, stream);
    if (e != hipSuccess) fprintf(stderr, "kernel_launch: cooperative launch failed: %s (grid %d)\n", hipGetErrorString(e), grid);
#endif
}
```
